# Optimizing an MI355X kernel written in HIP

```python
import math
import jax, jax.numpy as jnp
from jax import lax
import numpy as np

D_MODEL = 1024
BATCH = 8
SEQ = 4096
DEPTH = 2

DA_HEADS = 4
DA_QK_DIM = 64
DA_V_DIM = 2 * DA_QK_DIM
RET_HEADS = 4
RET_QK_DIM = 64
RET_V_DIM = 64
RET_CHUNK = 128
SC_WIDTH = 256
SC_GROUPS = 4
CONV_W = 3
D_FF = 2816
REL_BUCKETS = 32
REL_MAX_DIST = 128
ROPE_THETA = 10000.0
Q_BLOCK = 128
EPS = 1e-6
N_BRANCH = 3

DA_QK_W = DA_HEADS * 2 * DA_QK_DIM
DA_V_W = DA_HEADS * DA_V_DIM
RET_QK_W = RET_HEADS * RET_QK_DIM
RET_V_W = RET_HEADS * RET_V_DIM
IN_SPLITS = (DA_QK_W, DA_QK_W, DA_V_W,
             RET_QK_W, RET_QK_W, RET_V_W, RET_V_W,
             SC_WIDTH, SC_WIDTH, SC_WIDTH,
             N_BRANCH * D_MODEL)
IN_WIDTH = 2 * DA_QK_W + DA_V_W + 2 * RET_QK_W + 2 * RET_V_W + 3 * SC_WIDTH + N_BRANCH * D_MODEL

kernel_name = "hybrid_gated_diffattn_retention_shortconv"


def rmsnorm(x, g):
    xf = x.astype(jnp.float32)
    y = xf * lax.rsqrt(jnp.mean(xf * xf, axis=-1, keepdims=True) + EPS)
    return (y * g.astype(jnp.float32)).astype(x.dtype)


def causal_dwconv(x, w, b):
    S = x.shape[1]
    K = w.shape[0]
    xp = jnp.pad(x, ((0, 0), (K - 1, 0), (0, 0)))
    y = b + xp[:, 0:S] * w[0]
    for k in range(1, K):
        y = y + xp[:, k:k + S] * w[k]
    return y


def rel_bucket(n):
    max_exact = REL_BUCKETS // 2
    nf = jnp.maximum(n, 1).astype(jnp.float32)
    large = max_exact + (jnp.log(nf / max_exact) / math.log(REL_MAX_DIST / max_exact)
                         * (REL_BUCKETS - max_exact)).astype(jnp.int32)
    large = jnp.minimum(large, REL_BUCKETS - 1)
    return jnp.where(n < max_exact, n, large)


def rotary(x, pos):
    d = x.shape[-1]
    half = d // 2
    inv = ROPE_THETA ** (-jnp.arange(half, dtype=jnp.float32) / half)
    ang = pos.astype(jnp.float32)[:, None] * inv[None, :]
    cos = jnp.cos(ang)[None, :, None, :]
    sin = jnp.sin(ang)[None, :, None, :]
    xf = x.astype(jnp.float32)
    x1, x2 = xf[..., :half], xf[..., half:]
    return jnp.concatenate([x1 * cos - x2 * sin, x2 * cos + x1 * sin], axis=-1)


def diff_attention(q, k, v, lam, bias_dist):
    B, S, H = q.shape[0], q.shape[1], q.shape[2]
    qh = jnp.transpose(q, (0, 2, 3, 1, 4)).astype(jnp.float32)
    kh = jnp.transpose(k, (0, 2, 3, 1, 4)).astype(jnp.float32)
    vh = jnp.transpose(v, (0, 2, 1, 3)).astype(jnp.float32)
    kpos = jnp.arange(S)
    neg = jnp.finfo(jnp.float32).min

    def block(i):
        start = i * Q_BLOCK
        qb = lax.dynamic_slice_in_dim(qh, start, Q_BLOCK, axis=3)
        dist = (start + jnp.arange(Q_BLOCK))[:, None] - kpos[None, :]
        bias = jnp.transpose(bias_dist[jnp.maximum(dist, 0)], (2, 0, 1)).astype(jnp.float32)
        s = jnp.einsum('bhmqd,bhmkd->bhmqk', qb, kh) + bias[None, :, None]
        s = jnp.where(dist >= 0, s, neg)
        p = jax.nn.softmax(s, axis=-1)
        a = p[:, :, 0] - lam * p[:, :, 1]
        return jnp.einsum('bhqk,bhke->bhqe', a, vh)

    out = lax.map(block, jnp.arange(S // Q_BLOCK))
    return jnp.transpose(out, (1, 0, 3, 2, 4)).reshape(B, S, H, -1)


def retention(q, k, v):
    B, S, H, dk = q.shape
    dv = v.shape[-1]
    C = RET_CHUNK
    N = S // C
    lg = jnp.log(1.0 - 2.0 ** (-5.0 - jnp.arange(H, dtype=jnp.float32)))
    to_chunks = lambda t: jnp.transpose(t.astype(jnp.float32).reshape(B, N, C, H, t.shape[-1]), (0, 3, 1, 2, 4))
    qc, kc, vc = to_chunks(q), to_chunks(k), to_chunks(v)
    idx = jnp.arange(C, dtype=jnp.float32)
    diff = idx[:, None] - idx[None, :]
    d_intra = jnp.where(diff[None] >= 0, jnp.exp(lg[:, None, None] * jnp.maximum(diff, 0.0)[None]), 0.0)
    inner = jnp.einsum('bhncd,bhnjd->bhncj', qc, kc) * d_intra[None, :, None]
    inner = jnp.einsum('bhncj,bhnje->bhnce', inner, vc)
    k_dec = kc * jnp.exp(lg[:, None] * (C - 1 - idx)[None])[None, :, None, :, None]
    kv = jnp.einsum('bhncd,bhnce->nbhde', k_dec, vc)
    chunk_decay = jnp.exp(lg * C)[None, :, None, None]

    def step(R, kv_n):
        return R * chunk_decay + kv_n, R

    _, R_prev = lax.scan(step, jnp.zeros((B, H, dk, dv), jnp.float32), kv)
    q_dec = qc * jnp.exp(lg[:, None] * (idx + 1.0)[None])[None, :, None, :, None]
    cross = jnp.einsum('bhncd,nbhde->bhnce', q_dec, R_prev)
    o = inner + cross
    return jnp.transpose(o, (0, 2, 3, 1, 4)).reshape(B, S, H, dv)


def setup_inputs(seed: int = 0) -> dict:
    key = jax.random.key(seed)
    ks = jax.random.split(key, 24)
    f32 = jnp.float32
    nrm = lambda k, shape, s: jax.random.normal(k, shape, f32) * s
    gain = lambda k, shape: 1.0 + 0.05 * jax.random.normal(k, shape, f32)
    return {
        "x": nrm(ks[0], (BATCH, SEQ, D_MODEL), 1.0),
        "rel_bias": nrm(ks[1], (REL_BUCKETS, DA_HEADS), 0.5),
        "norm_mix_g": gain(ks[2], (DEPTH, D_MODEL)),
        "w_in": nrm(ks[3], (DEPTH, D_MODEL, IN_WIDTH), D_MODEL ** -0.5),
        "b_gate": nrm(ks[4], (DEPTH, N_BRANCH * D_MODEL), 0.02),
        "da_q_norm_g": gain(ks[5], (DEPTH, DA_QK_DIM)),
        "da_k_norm_g": gain(ks[6], (DEPTH, DA_QK_DIM)),
        "da_lambda": nrm(ks[7], (DEPTH, 4, DA_QK_DIM), 0.1),
        "da_subln_g": gain(ks[8], (DEPTH, DA_V_DIM)),
        "ret_norm_g": gain(ks[9], (DEPTH, RET_V_DIM)),
        "sc_conv_w": nrm(ks[10], (DEPTH, CONV_W, SC_WIDTH), CONV_W ** -0.5),
        "sc_conv_b": nrm(ks[11], (DEPTH, SC_WIDTH), 0.02),
        "w_branch_da": nrm(ks[12], (DEPTH, DA_V_W, D_MODEL), DA_V_W ** -0.5),
        "w_branch_ret": nrm(ks[13], (DEPTH, RET_V_W, D_MODEL), RET_V_W ** -0.5),
        "w_branch_sc": nrm(ks[14], (DEPTH, SC_WIDTH, D_MODEL), SC_WIDTH ** -0.5),
        "w_out": nrm(ks[15], (DEPTH, D_MODEL, D_MODEL), 0.5 * D_MODEL ** -0.5),
        "norm_ffn_g": gain(ks[16], (DEPTH, D_MODEL)),
        "w_ffn_in": nrm(ks[17], (DEPTH, D_MODEL, 2 * D_FF), D_MODEL ** -0.5),
        "ffn_conv_w": nrm(ks[18], (DEPTH, CONV_W, D_FF), CONV_W ** -0.5),
        "ffn_conv_b": nrm(ks[19], (DEPTH, D_FF), 0.02),
        "w_ffn_out": nrm(ks[20], (DEPTH, D_FF, D_MODEL), 0.5 * D_FF ** -0.5),
    }


def reference(x, rel_bias, norm_mix_g, w_in, b_gate, da_q_norm_g, da_k_norm_g, da_lambda,
              da_subln_g, ret_norm_g, sc_conv_w, sc_conv_b, w_branch_da, w_branch_ret,
              w_branch_sc, w_out, norm_ffn_g, w_ffn_in, ffn_conv_w, ffn_conv_b, w_ffn_out):
    B, S, D = x.shape
    pos = jnp.arange(S)
    bias_dist = rel_bias[rel_bucket(pos)]
    offs = np.cumsum(IN_SPLITS)[:-1].tolist()
    for l in range(DEPTH):
        h = rmsnorm(x, norm_mix_g[l])
        proj = jnp.einsum('bsd,de->bse', h, w_in[l])
        (da_q, da_k, da_v, r_q, r_k, r_v, r_g,
         sc_b, sc_c, sc_x, gate_pre) = jnp.split(proj, offs, axis=-1)

        lam_init = 0.8 - 0.6 * math.exp(-0.3 * l)
        lp = da_lambda[l].astype(jnp.float32)
        lam = jnp.exp(jnp.sum(lp[0] * lp[1])) - jnp.exp(jnp.sum(lp[2] * lp[3])) + lam_init
        q = rmsnorm(da_q.reshape(B, S, DA_HEADS, 2, DA_QK_DIM), da_q_norm_g[l]) * (DA_QK_DIM ** -0.5)
        k = rmsnorm(da_k.reshape(B, S, DA_HEADS, 2, DA_QK_DIM), da_k_norm_g[l])
        v = da_v.reshape(B, S, DA_HEADS, DA_V_DIM)
        o_da = diff_attention(q, k, v, lam, bias_dist)
        o_da = (rmsnorm(o_da, da_subln_g[l]) * (1.0 - lam_init)).astype(x.dtype).reshape(B, S, DA_V_W)

        rq = rotary(r_q.reshape(B, S, RET_HEADS, RET_QK_DIM), pos)
        rk = rotary(r_k.reshape(B, S, RET_HEADS, RET_QK_DIM), pos) * (RET_QK_DIM ** -0.5)
        rv = r_v.reshape(B, S, RET_HEADS, RET_V_DIM)
        o_ret = rmsnorm(retention(rq, rk, rv), ret_norm_g[l]).reshape(B, S, RET_V_W)
        o_ret = (o_ret * jax.nn.silu(r_g.astype(jnp.float32))).astype(x.dtype)

        o_sc = sc_b * causal_dwconv(sc_c * sc_x, sc_conv_w[l], sc_conv_b[l])

        gates = jax.nn.sigmoid((gate_pre + b_gate[l]).astype(jnp.float32)).astype(x.dtype)
        gates = gates.reshape(B, S, N_BRANCH, D)
        y = (gates[:, :, 0] * jnp.einsum('bse,ed->bsd', o_da, w_branch_da[l])
             + gates[:, :, 1] * jnp.einsum('bse,ed->bsd', o_ret, w_branch_ret[l])
             + gates[:, :, 2] * jnp.einsum('bse,ed->bsd', o_sc, w_branch_sc[l]))
        x = x + jnp.einsum('bsd,de->bse', y, w_out[l])

        h = rmsnorm(x, norm_ffn_g[l])
        gu = jnp.einsum('bsd,df->bsf', h, w_ffn_in[l])
        g_ff, u_ff = gu[..., :D_FF], gu[..., D_FF:]
        g_ff = causal_dwconv(g_ff, ffn_conv_w[l], ffn_conv_b[l])
        x = x + jnp.einsum('bsf,fd->bsd', jax.nn.silu(g_ff) * u_ff, w_ffn_out[l])
    return x
```

```cpp
#include <hip/hip_runtime.h>
#include <hip/hip_cooperative_groups.h>
#include <cstdio>
#include <cstdint>
namespace cg = cooperative_groups;

#ifndef MK_ONE_LAUNCH
#define MK_ONE_LAUNCH 1
#endif

#define LAS __attribute__((address_space(3)))
typedef unsigned short bf16_t;
typedef short bf16x8 __attribute__((ext_vector_type(8)));
typedef float f32x4 __attribute__((ext_vector_type(4)));
typedef unsigned u32x4 __attribute__((ext_vector_type(4)));
typedef unsigned u32x2 __attribute__((ext_vector_type(2)));

constexpr int NB = 8, SEQ = 4096, DM = 1024, MT = NB * SEQ, INW = 6400, DFF = 2816, DEPTH = 2;
constexpr float EPS = 1e-6f;
constexpr float LOG2E = 1.4426950408889634f;
constexpr float C2 = 0.125f * LOG2E;
constexpr int NWAVES = 8, NTHR = 512;
constexpr size_t MiB = 1u << 20;
constexpr size_t WS_ROT = 1 * MiB;
constexpr size_t WS_BT = 2 * MiB;
constexpr size_t WS_LAM = 2 * MiB + 4096;
constexpr size_t WS_RS = 3 * MiB;
constexpr size_t WS_WIN = 4 * MiB;
constexpr size_t WS_WBR = WS_WIN + (size_t)INW * DM * 2;
constexpr size_t WS_WOUT = WS_WBR + 2 * MiB;
constexpr size_t WS_WFFI = WS_WOUT + 2 * MiB;
constexpr size_t WS_WFFO = WS_WFFI + (size_t)2 * DFF * DM * 2;
constexpr size_t WS_XB = 38 * MiB;
constexpr size_t WS_R = 102 * MiB;
constexpr size_t R_Q = 0, R_K = 32 * MiB, R_V = 64 * MiB, R_RQ = 96 * MiB, R_RK = 112 * MiB, R_RV = 128 * MiB, R_RG = 144 * MiB,
                 R_SCB = 160 * MiB, R_SCC = 176 * MiB, R_SCX = 192 * MiB, R_GATES = 208 * MiB;
constexpr size_t R_OCAT = 0, R_Y = 64 * MiB, R_G = 0, R_U = 176 * MiB;
constexpr size_t WS_KV = 502 * MiB;
constexpr size_t WS_SSQ = 510 * MiB;
constexpr size_t WS_END = 512 * MiB;
constexpr size_t WS_HX = 256 * 1024;
constexpr size_t WS_PART = WS_KV;
static_assert(WS_WFFO + (size_t)DM * DFF * 2 <= WS_XB, "weights fit");

constexpr int LDS_BYTES = 147456;

#define LDS_WAIT() asm volatile("s_waitcnt lgkmcnt(0)" ::: "memory")

__device__ __forceinline__ unsigned cvt_pk_bf16(float lo, float hi) { unsigned r; asm volatile("v_cvt_pk_bf16_f32 %0, %1, %2" : "=v"(r) : "v"(lo), "v"(hi)); return r; }
__device__ __forceinline__ float bflo(unsigned w) { return __uint_as_float(w << 16); }
__device__ __forceinline__ float bfhi(unsigned w) { return __uint_as_float(w & 0xffff0000u); }
__device__ __forceinline__ float bf2f(bf16_t b) { return __uint_as_float((unsigned)b << 16); }
__device__ __forceinline__ float sigmoidf_(float v) { return __builtin_amdgcn_rcpf(1.f + __expf(-v)); }

__device__ __forceinline__ float row_scale(const float* ssq, int row) {
    const f32x4* p = (const f32x4*)(ssq + (size_t)row * 16); const f32x4 a = p[0], b = p[1], c = p[2], d = p[3];
    const float s = ((a.x + a.y) + (a.z + a.w)) + ((b.x + b.y) + (b.z + b.w)) + ((c.x + c.y) + (c.z + c.w)) + ((d.x + d.y) + (d.z + d.w));
    return rsqrtf(s * (1.f / DM) + EPS);
}

namespace pg8 {
constexpr int BM = 256, BK = 64, HALF = 128, HTB = HALF * BK * 2, STAGE_BYTES = 8 * HTB, NXCD = 8, WGM = 2;
__host__ __device__ __forceinline__ int lds_byte(int r, int c) { const int st = (r >> 4) * 2 + (c >> 5), rr = r & 15, cc = c & 31, ob = rr * 64 + cc * 2; return st * 1024 + (ob ^ (((ob >> 9) & 1) << 5)); }
__host__ __device__ __forceinline__ void stage_rc(int b, int& R, int& C) { const int st = b / 1024, sb = b % 1024, swz = sb ^ (((sb >> 9) & 1) << 5); R = (st >> 1) * 16 + swz / 64; C = (st & 1) * 32 + (swz % 64) / 2; }
__host__ __device__ __forceinline__ int perm32(int rho) { const int n = rho >> 4, i = rho & 15; return 8 * (i >> 2) + 4 * n + (i & 3); }

struct Unit { int pm, pn, koff, nt, seg; };
struct Gemm { const bf16_t* A; const bf16_t* Bt; int pitch; };

struct Order {
    int nM, nN, nwg, G, c, nseg, nt0;
    __device__ void init(int M, int N, int G_, int c_, int nseg_, int nt0_) { nM = M / BM; nN = N / BM; nwg = nM * nN; G = G_; c = c_; nseg = nseg_; nt0 = nt0_; }
    __device__ bool next(int i, Unit& u) const {
        int tile = i, seg = 0;
        if (nseg == 3) { tile = i / 3; seg = i - tile * 3; }
        const long L = (long)tile * G + c; if (L >= nwg) return false;
        int wgid = (int)L; { const int q = nwg / NXCD, r = nwg % NXCD, xcd = wgid % NXCD, off = wgid / NXCD; wgid = (xcd < r ? xcd * (q + 1) : r * (q + 1) + (xcd - r) * q) + off; }
        const int nig = WGM * nN, gid = wgid / nig, fm = gid * WGM, gsz = (nM - fm) < WGM ? (nM - fm) : WGM;
        u.pm = fm + ((wgid % nig) % gsz); u.pn = (wgid % nig) / gsz; u.seg = seg;
        if (nseg == 3) { u.koff = seg == 0 ? 0 : (seg == 1 ? 512 : 768); u.nt = seg == 0 ? 8 : 4; }
        else { u.koff = 0; u.nt = nt0; }
        return true;
    }
};

template <class Epi, class Sched>
__device__ __forceinline__ void gemm_phase(LAS unsigned char* lds, const Gemm g, const Sched& S, const Epi& E, const int tid) {
    const int wid = __builtin_amdgcn_readfirstlane(tid >> 6), lane = tid & 63, wr = wid >> 2, wc = wid & 3, fr = lane & 15, fq = lane >> 4;
    const int P = g.pitch;
    unsigned voffA[2], voffB[2];
#pragma unroll
    for (int i = 0; i < 2; ++i) { int R, C; stage_rc(tid * 16 + i * 8192, R, C); const int Rb = Epi::PERM ? ((R & ~31) + perm32(R & 31)) : R;
        voffA[i] = (unsigned)(R * P + C) * 2u; voffB[i] = (unsigned)(Rb * P + C) * 2u; }
    const size_t kstep = (size_t)(BK * 2);
    const size_t hstep = (size_t)HALF * P * 2;
    const size_t tstep = 2 * hstep;
    const unsigned ldsw = (unsigned)wid * 1024u;
    const int aoff = lds_byte(wr * 64 + fr, fq * 8), boff = lds_byte(wc * 32 + fr, fq * 8);
#define PG8_SA(b, h) (((b) * 2 + (h)) * HTB)
#define PG8_SB(b, h) ((4 + (b) * 2 + (h)) * HTB)
#define PG8_STAGE(bufoff, gbase, voff) do { _Pragma("unroll") for (int _i = 0; _i < 2; ++_i) \
        __builtin_amdgcn_global_load_lds((const unsigned*)((const char*)(gbase) + (voff)[_i]), (LAS unsigned*)(lds + (bufoff) + ldsw + _i * 8192), 16, 0, 0); } while (0)
#define PG8_LDA(dst, b, h) do { _Pragma("unroll") for (int m = 0; m < 4; ++m) _Pragma("unroll") for (int k = 0; k < 2; ++k) dst[m][k] = *(const LAS bf16x8*)(lds + PG8_SA(b, h) + aoff + m * 2048 + k * 1024); } while (0)
#define PG8_LDB(dst, b, h) do { _Pragma("unroll") for (int n = 0; n < 2; ++n) _Pragma("unroll") for (int k = 0; k < 2; ++k) dst[n][k] = *(const LAS bf16x8*)(lds + PG8_SB(b, h) + boff + n * 2048 + k * 1024); } while (0)
#define PG8_MMA(ai, bj, At, Bt) do { __builtin_amdgcn_s_setprio(1); _Pragma("unroll") for (int m = 0; m < 4; ++m) _Pragma("unroll") for (int n = 0; n < 2; ++n) _Pragma("unroll") for (int k = 0; k < 2; ++k) \
        acc[ai][bj][m][n] = __builtin_amdgcn_mfma_f32_16x16x32_bf16(Bt[n][k], At[m][k], acc[ai][bj][m][n], 0, 0, 0); __builtin_amdgcn_s_setprio(0); } while (0)
#define PG8_WAIT_V(n) asm volatile("s_waitcnt vmcnt(" #n ")" ::: "memory")
#define PG8_WAIT_L(n) asm volatile("s_waitcnt lgkmcnt(" #n ")" ::: "memory")
#define PG8_BAR __builtin_amdgcn_s_barrier()
#define PG8_SCHED __builtin_amdgcn_sched_barrier(0)
    Unit cur, nxt; int ui = 0;
    if (!S.next(0, cur)) return;
    f32x4 acc[2][2][4][2];
#pragma unroll
    for (int a = 0; a < 2; ++a)
#pragma unroll
        for (int b = 0; b < 2; ++b)
#pragma unroll
            for (int m = 0; m < 4; ++m)
#pragma unroll
                for (int n = 0; n < 2; ++n) acc[a][b][m][n] = (f32x4){0.f, 0.f, 0.f, 0.f};
    bf16x8 At[4][2], B0[2][2], B1[2][2];
    const char* cA = (const char*)g.A + (size_t)cur.pm * tstep + (size_t)cur.koff * 2; const char* cB = (const char*)g.Bt + (size_t)cur.pn * tstep + (size_t)cur.koff * 2;
    E.prep(cur, lds + STAGE_BYTES, tid);
    PG8_STAGE(PG8_SB(0, 0), cB, voffB); PG8_STAGE(PG8_SB(0, 1), cB + hstep, voffB); PG8_STAGE(PG8_SA(0, 0), cA, voffA); PG8_STAGE(PG8_SA(0, 1), cA + hstep, voffA);
    if (wr == 1) PG8_BAR;
    PG8_WAIT_V(2); PG8_BAR;
    PG8_STAGE(PG8_SB(1, 0), cB + kstep, voffB); PG8_STAGE(PG8_SA(1, 0), cA + kstep, voffA); PG8_STAGE(PG8_SB(1, 1), cB + hstep + kstep, voffB);
    PG8_WAIT_V(6); PG8_BAR;
    for (;;) {
        const bool has_next = S.next(ui + 1, nxt);
        const char* nA = has_next ? (const char*)g.A + (size_t)nxt.pm * tstep + (size_t)nxt.koff * 2 : cA; const char* nB = has_next ? (const char*)g.Bt + (size_t)nxt.pn * tstep + (size_t)nxt.koff * 2 : cB;
        const int nt = cur.nt;
        for (int t = 0; t < nt; t += 2) {
            if constexpr (Epi::CHAIN) { if (t == 8 || t == 12) { E.mid(acc, cur, t == 8 ? 0 : 1, wr, wc, fr, fq); PG8_SCHED; } }
            const bool last = (t == nt - 2);
            const char* a1 = cA + (size_t)(t + 1) * kstep;
            const char* a2 = last ? nA : cA + (size_t)(t + 2) * kstep; const char* b2 = last ? nB : cB + (size_t)(t + 2) * kstep;
            const char* a3 = a2 + kstep; const char* b3 = b2 + kstep;
            PG8_LDB(B0, 0, 0); PG8_LDB(B1, 0, 1); PG8_SCHED; PG8_LDA(At, 0, 0); PG8_STAGE(PG8_SA(1, 1), a1 + hstep, voffA);
            PG8_WAIT_V(8); PG8_WAIT_L(0); PG8_BAR; PG8_MMA(0, 0, At, B0); PG8_MMA(0, 1, At, B1); PG8_BAR; PG8_SCHED;
            PG8_LDA(At, 0, 1); PG8_STAGE(PG8_SB(0, 0), b2, voffB); PG8_STAGE(PG8_SB(0, 1), b2 + hstep, voffB); PG8_STAGE(PG8_SA(0, 0), a2, voffA);
            PG8_WAIT_V(8); PG8_WAIT_L(0); PG8_BAR; PG8_MMA(1, 0, At, B0); PG8_MMA(1, 1, At, B1); PG8_BAR; PG8_SCHED;
            PG8_LDB(B0, 1, 0); PG8_LDB(B1, 1, 1); PG8_SCHED; PG8_LDA(At, 1, 0); PG8_STAGE(PG8_SA(0, 1), a2 + hstep, voffA);
            PG8_WAIT_V(8); PG8_WAIT_L(0); PG8_BAR; PG8_MMA(0, 0, At, B0); PG8_MMA(0, 1, At, B1); PG8_BAR; PG8_SCHED;
            PG8_LDA(At, 1, 1); PG8_STAGE(PG8_SB(1, 0), b3, voffB); PG8_STAGE(PG8_SB(1, 1), b3 + hstep, voffB); PG8_STAGE(PG8_SA(1, 0), a3, voffA);
            PG8_WAIT_V(8); PG8_WAIT_L(0); PG8_BAR; PG8_MMA(1, 0, At, B0); PG8_MMA(1, 1, At, B1); PG8_BAR; PG8_SCHED;
        }
        if (wr == 0) PG8_BAR;
        E(acc, cur, wr, wc, fr, fq, lds + STAGE_BYTES + (ui & 1) * 2048);
        if (!has_next) break;
        if (!(Epi::CHAIN && nxt.seg != 0))
#pragma unroll
        for (int a = 0; a < 2; ++a)
#pragma unroll
            for (int b = 0; b < 2; ++b)
#pragma unroll
                for (int m = 0; m < 4; ++m)
#pragma unroll
                    for (int n = 0; n < 2; ++n) acc[a][b][m][n] = (f32x4){0.f, 0.f, 0.f, 0.f};
        cur = nxt; cA = nA; cB = nB; ++ui;
        E.prep(cur, lds + STAGE_BYTES + (ui & 1) * 2048, tid);
        if (wr == 1) PG8_BAR;
    }
    PG8_WAIT_V(0);
    PG8_BAR;
#undef PG8_SA
#undef PG8_SB
#undef PG8_STAGE
#undef PG8_LDA
#undef PG8_LDB
#undef PG8_MMA
#undef PG8_WAIT_V
#undef PG8_WAIT_L
#undef PG8_BAR
#undef PG8_SCHED
}
}

template <int MODE> struct EpiSplit {
    static constexpr bool PERM = true, CHAIN = false;
    unsigned char* R; const float* ssq; const float* bgate; const float* qg; const float* kg; const float* rot;
    __device__ __forceinline__ void prep(const pg8::Unit& u, LAS unsigned char* sp, int tid) const {
        if (tid < 256) ((LAS float*)sp)[tid] = row_scale(ssq, u.pm * 256 + tid);
        else if (MODE == 0 && u.pn >= 13) ((LAS float*)sp)[tid] = bgate[(u.pn - 13) * 256 + (tid - 256)];
    }
    __device__ __forceinline__ void operator()(const f32x4 (&acc)[2][2][4][2], const pg8::Unit& u, int wr, int wc, int fr, int fq, LAS unsigned char* sp) const {
        const LAS float* rsl = (const LAS float*)sp + wr * 64 + fr; const LAS float* bsl = (const LAS float*)sp + 256;
        const int pn = u.pn; bf16_t* dst; int pitch, colt, act = 0;
        if (MODE == 0) {
            if (pn < 6) { dst = (bf16_t*)(R + (size_t)(pn >> 1) * (32 * MiB)); pitch = 512; colt = (pn & 1) * 256; act = (pn < 4) ? 3 : 0; }
            else if (pn < 13) { dst = (bf16_t*)(R + R_RQ + (size_t)(pn - 6) * (16 * MiB)); pitch = 256; colt = 0; act = (pn == 9) ? 1 : ((pn < 8) ? 4 : 0); }
            else { dst = (bf16_t*)(R + R_GATES); pitch = 3072; colt = (pn - 13) * 256; act = 2; }
        } else {
            if (pn < 11) { dst = (bf16_t*)(R + R_G); colt = pn * 256; } else { dst = (bf16_t*)(R + R_U); colt = (pn - 11) * 256; }
            pitch = DFF;
        }
        const int row0 = u.pm * 256 + wr * 64 + fr;
        if (MODE == 0 && act >= 3) {
            const int cwh = 64 * wc + 8 * fq;
            const float* gn = (pn < 2) ? qg : kg; const float osc = (pn < 2) ? C2 : ((pn == 7) ? 0.125f : 1.f);
#pragma unroll
            for (int ai = 0; ai < 2; ++ai)
#pragma unroll
                for (int m = 0; m < 4; ++m) {
                    const int row = row0 + ai * 128 + m * 16; const float s = rsl[ai * 128 + m * 16];
                    f32x4 v[2][2];
#pragma unroll
                    for (int bj = 0; bj < 2; ++bj)
#pragma unroll
                        for (int n = 0; n < 2; ++n) v[bj][n] = acc[ai][bj][m][n] * s;
                    if (act == 3) {
                        float q = 0.f;
#pragma unroll
                        for (int bj = 0; bj < 2; ++bj)
#pragma unroll
                            for (int n = 0; n < 2; ++n) q += (v[bj][n][0] * v[bj][n][0] + v[bj][n][1] * v[bj][n][1]) + (v[bj][n][2] * v[bj][n][2] + v[bj][n][3] * v[bj][n][3]);
                        q += __shfl_xor(q, 16); q += __shfl_xor(q, 32);
                        const float ri = rsqrtf(q * (1.f / 64.f) + EPS) * osc;
#pragma unroll
                        for (int bj = 0; bj < 2; ++bj)
#pragma unroll
                            for (int n = 0; n < 2; ++n) { const f32x4 g = *(const f32x4*)(gn + 32 * bj + 8 * fq + 4 * n); v[bj][n] = v[bj][n] * g * ri; }
                    } else {
                        const int pos = row & (SEQ - 1);
#pragma unroll
                        for (int n = 0; n < 2; ++n) { const f32x4 cs = *(const f32x4*)(rot + pos * 32 + 8 * fq + 4 * n), sn = *(const f32x4*)(rot + 4096 * 32 + pos * 32 + 8 * fq + 4 * n);
                            const f32x4 x1 = v[0][n], x2 = v[1][n]; v[0][n] = (x1 * cs - x2 * sn) * osc; v[1][n] = (x2 * cs + x1 * sn) * osc; }
                    }
#pragma unroll
                    for (int bj = 0; bj < 2; ++bj) { u32x4 w; w.x = cvt_pk_bf16(v[bj][0][0], v[bj][0][1]); w.y = cvt_pk_bf16(v[bj][0][2], v[bj][0][3]); w.z = cvt_pk_bf16(v[bj][1][0], v[bj][1][1]); w.w = cvt_pk_bf16(v[bj][1][2], v[bj][1][3]);
                        *(u32x4*)(dst + (size_t)row * pitch + colt + cwh + 32 * bj) = w; }
                }
            return;
        }
        const int cw0 = wc * 32 + 8 * fq;
#pragma unroll
        for (int ai = 0; ai < 2; ++ai)
#pragma unroll
            for (int m = 0; m < 4; ++m) {
                const int row = row0 + ai * 128 + m * 16; const float s = rsl[ai * 128 + m * 16];
#pragma unroll
                for (int bj = 0; bj < 2; ++bj) {
                    f32x4 v0 = acc[ai][bj][m][0] * s, v1 = acc[ai][bj][m][1] * s;
                    const int col = colt + bj * 128 + cw0;
                    if (act == 2) { const f32x4 b0 = *(const LAS f32x4*)(bsl + bj * 128 + cw0), b1 = *(const LAS f32x4*)(bsl + bj * 128 + cw0 + 4);
                        v0 += b0; v1 += b1;
#pragma unroll
                        for (int j = 0; j < 4; ++j) { v0[j] = sigmoidf_(v0[j]); v1[j] = sigmoidf_(v1[j]); } }
                    else if (act == 1) {
#pragma unroll
                        for (int j = 0; j < 4; ++j) { v0[j] = v0[j] * sigmoidf_(v0[j]); v1[j] = v1[j] * sigmoidf_(v1[j]); } }
                    u32x4 w; w.x = cvt_pk_bf16(v0[0], v0[1]); w.y = cvt_pk_bf16(v0[2], v0[3]); w.z = cvt_pk_bf16(v1[0], v1[1]); w.w = cvt_pk_bf16(v1[2], v1[3]);
                    *(u32x4*)(dst + (size_t)row * pitch + col) = w;
                }
            }
    }
};
struct EpiAcc {
    static constexpr bool PERM = true, CHAIN = true;
    const bf16_t* gates; bf16_t* Y;
    __device__ __forceinline__ void mid(f32x4 (&acc)[2][2][4][2], const pg8::Unit& u, int seg, int wr, int wc, int fr, int fq) const {
        asm volatile("" : "+v"(fr), "+v"(fq));
        const int row0 = u.pm * 256 + wr * 64 + fr, col0 = u.pn * 256 + wc * 32 + 8 * fq;
#pragma unroll
        for (int ai = 0; ai < 2; ++ai)
#pragma unroll
            for (int m = 0; m < 4; ++m) {
                const bf16_t* gp = gates + (size_t)(row0 + ai * 128 + m * 16) * 3072 + seg * 1024 + col0;
#pragma unroll
                for (int bj = 0; bj < 2; ++bj) {
                    const u32x4 gw = *(const u32x4*)(gp + bj * 128), hw = *(const u32x4*)(gp + 1024 + bj * 128);
                    f32x4 v0 = acc[ai][bj][m][0], v1 = acc[ai][bj][m][1];
                    v0[0] *= bflo(gw.x) * __builtin_amdgcn_rcpf(fmaxf(bflo(hw.x), 1e-20f)); v0[1] *= bfhi(gw.x) * __builtin_amdgcn_rcpf(fmaxf(bfhi(hw.x), 1e-20f));
                    v0[2] *= bflo(gw.y) * __builtin_amdgcn_rcpf(fmaxf(bflo(hw.y), 1e-20f)); v0[3] *= bfhi(gw.y) * __builtin_amdgcn_rcpf(fmaxf(bfhi(hw.y), 1e-20f));
                    v1[0] *= bflo(gw.z) * __builtin_amdgcn_rcpf(fmaxf(bflo(hw.z), 1e-20f)); v1[1] *= bfhi(gw.z) * __builtin_amdgcn_rcpf(fmaxf(bfhi(hw.z), 1e-20f));
                    v1[2] *= bflo(gw.w) * __builtin_amdgcn_rcpf(fmaxf(bflo(hw.w), 1e-20f)); v1[3] *= bfhi(gw.w) * __builtin_amdgcn_rcpf(fmaxf(bfhi(hw.w), 1e-20f));
                    acc[ai][bj][m][0] = v0; acc[ai][bj][m][1] = v1;
                }
                if (m & 1) asm volatile("" ::: "memory");
            }
    }
    __device__ __forceinline__ void prep(const pg8::Unit&, LAS unsigned char*, int) const {}
    __device__ __forceinline__ void operator()(f32x4 (&acc)[2][2][4][2], const pg8::Unit& u, int wr, int wc, int fr, int fq, LAS unsigned char*) const {
        const int row0 = u.pm * 256 + wr * 64 + fr, col0 = u.pn * 256 + wc * 32 + 8 * fq;
#pragma unroll
        for (int ai = 0; ai < 2; ++ai)
#pragma unroll
            for (int m = 0; m < 4; ++m) {
                const int row = row0 + ai * 128 + m * 16;
#pragma unroll
                for (int bj = 0; bj < 2; ++bj) {
                    const int col = col0 + bj * 128;
                    const u32x4 gw = *(const u32x4*)(gates + (size_t)row * 3072 + 2048 + col);
                    const f32x4 v0 = acc[ai][bj][m][0], v1 = acc[ai][bj][m][1];
                    u32x4 w; w.x = cvt_pk_bf16(v0[0] * bflo(gw.x), v0[1] * bfhi(gw.x)); w.y = cvt_pk_bf16(v0[2] * bflo(gw.y), v0[3] * bfhi(gw.y));
                    w.z = cvt_pk_bf16(v1[0] * bflo(gw.z), v1[1] * bfhi(gw.z)); w.w = cvt_pk_bf16(v1[2] * bflo(gw.w), v1[3] * bfhi(gw.w));
                    *(u32x4*)(Y + (size_t)row * DM + col) = w;
                }
            }
    }
};
struct EpiRes {
    static constexpr bool PERM = false, CHAIN = false;
    const float* xin; float* xout; bf16_t* xb; float* ssq;
    __device__ __forceinline__ void prep(const pg8::Unit&, LAS unsigned char*, int) const {}
    __device__ __forceinline__ void operator()(const f32x4 (&acc)[2][2][4][2], const pg8::Unit& u, int wr, int wc, int fr, int fq, LAS unsigned char*) const {
        const int row0 = u.pm * 256 + wr * 64 + fr, col0 = u.pn * 256 + wc * 32 + 4 * fq;
#pragma unroll
        for (int ai = 0; ai < 2; ++ai)
#pragma unroll
            for (int m = 0; m < 4; ++m) {
                const int row = row0 + ai * 128 + m * 16; const size_t off = (size_t)row * DM + col0; float q = 0.f;
#pragma unroll
                for (int bj = 0; bj < 2; ++bj)
#pragma unroll
                    for (int n = 0; n < 2; ++n) { const size_t o = off + bj * 128 + n * 16; const f32x4 xv = *(const f32x4*)(xin + o) + acc[ai][bj][m][n]; *(f32x4*)(xout + o) = xv;
                        q += (xv[0] * xv[0] + xv[1] * xv[1]) + (xv[2] * xv[2] + xv[3] * xv[3]);
                        u32x2 w; w.x = cvt_pk_bf16(xv[0], xv[1]); w.y = cvt_pk_bf16(xv[2], xv[3]); *(u32x2*)(xb + o) = w; }
                q += __shfl_xor(q, 16); q += __shfl_xor(q, 32);
                if (fq == 0) ssq[(size_t)row * 16 + u.pn * 4 + wc] = q;
            }
    }
};

struct Args { const float* in[21]; float* out; unsigned char* ws; int ph_lo, ph_hi; };
typedef const __attribute__((address_space(4))) Args CArgs;
enum { I_X = 0, I_RELB, I_NMG, I_WIN, I_BGATE, I_QG, I_KG, I_LAM, I_SUBLN, I_RETG, I_SCW, I_SCB, I_WDA, I_WRET, I_WSC, I_WOUT, I_NFG, I_WFFI, I_FCW, I_FCB, I_WFFO };

__device__ __forceinline__ float wave_sum(float v) {
#pragma unroll
    for (int o = 1; o < 64; o <<= 1) v += __shfl_xor(v, o);
    return v;
}

__device__ __forceinline__ void transpose_item(const float* W, int N, const float* gain, bf16_t* WT, int dpitch, int dcol, LAS float* scr, int item, int lane, const bool headperm = false) {
    const int nblk = N / 32, kb = item / nblk, nb = item % nblk, k0 = 64 * kb, n0 = 32 * nb;
#pragma unroll
    for (int i = 0; i < 8; ++i) { const int kk = 8 * i + (lane >> 3), n4 = (lane & 7) * 4;
        f32x4 w = *(const f32x4*)(W + (size_t)(k0 + kk) * N + n0 + n4); if (gain) w *= gain[k0 + kk];
        LAS float* d = scr + kk * 33 + n4; d[0] = w.x; d[1] = w.y; d[2] = w.z; d[3] = w.w; }
    LDS_WAIT(); asm volatile("" ::: "memory");
    const int c = lane & 7;
#pragma unroll
    for (int j = 0; j < 4; ++j) { const int n = (lane >> 3) + 8 * j; const LAS float* s = scr + (8 * c) * 33 + n;
        u32x4 o; o.x = cvt_pk_bf16(s[0 * 33], s[1 * 33]); o.y = cvt_pk_bf16(s[2 * 33], s[3 * 33]); o.z = cvt_pk_bf16(s[4 * 33], s[5 * 33]); o.w = cvt_pk_bf16(s[6 * 33], s[7 * 33]);
        int nr = n0 + n;
        if (headperm && (nr < 1024 || (nr >= 1536 && nr < 2048))) { const int L = nr & 255; nr = (nr & ~255) + 128 * ((L >> 5) & 1) + 32 * (L >> 6) + (L & 31); }
        *(u32x4*)(WT + (size_t)nr * dpitch + dcol + k0 + 8 * c) = o; }
    LDS_WAIT(); asm volatile("" ::: "memory");
}
__device__ __forceinline__ int rel_bucket(int n) {
    if (n < 16) return n;
    const float v = logf((float)n / 16.f) / 2.0794415416798357f * 16.f;
    const int b = 16 + (int)v; return b < 31 ? b : 31;
}
__device__ __forceinline__ void xpass(const float* x, bf16_t* xb, float* rs, int gw, int NGW, int lane) {
    for (int m = gw; m < MT; m += NGW) {
        const f32x4* xr = (const f32x4*)(x + (size_t)m * DM) + lane;
        f32x4 v[4]; float s = 0.f;
#pragma unroll
        for (int j = 0; j < 4; ++j) { v[j] = xr[64 * j]; s += (v[j].x * v[j].x + v[j].y * v[j].y) + (v[j].z * v[j].z + v[j].w * v[j].w); }
        s = wave_sum(s);
        if (lane < 16) rs[(size_t)m * 16 + lane] = (lane == 0) ? s : 0.f;
        u32x2* o = (u32x2*)(xb + (size_t)m * DM) + lane;
#pragma unroll
        for (int j = 0; j < 4; ++j) { u32x2 w; w.x = cvt_pk_bf16(v[j].x, v[j].y); w.y = cvt_pk_bf16(v[j].z, v[j].w); o[64 * j] = w; }
    }
}
__device__ __forceinline__ void phase_W(CArgs& a, int l, LAS unsigned char* lds, const int tid, const int bx, const int G) {
    unsigned char* ws = a.ws;
    const int lane = tid & 63, wave = tid >> 6;
    const int gw = bx * NWAVES + wave, NGW = G * NWAVES;
    LAS float* scr = (LAS float*)(lds + wave * 16384);
    constexpr int I0 = 16 * 200, I1 = 8 * 32, I2 = 4 * 32, I3 = 4 * 32, I4 = 16 * 32, I5 = 16 * 176, I6 = 44 * 32;
    constexpr int NITEMS = I0 + I1 + I2 + I3 + I4 + I5 + I6;
    for (int it = gw; it < NITEMS; it += NGW) {
        int r = it;
        if (r < I0) { transpose_item(a.in[I_WIN] + (size_t)l * DM * INW, INW, a.in[I_NMG] + l * DM, (bf16_t*)(ws + WS_WIN), DM, 0, scr, r, lane, true); continue; } r -= I0;
        if (r < I1) { transpose_item(a.in[I_WDA] + (size_t)l * 512 * DM, DM, nullptr, (bf16_t*)(ws + WS_WBR), DM, 0, scr, r, lane); continue; } r -= I1;
        if (r < I2) { transpose_item(a.in[I_WRET] + (size_t)l * 256 * DM, DM, nullptr, (bf16_t*)(ws + WS_WBR), DM, 512, scr, r, lane); continue; } r -= I2;
        if (r < I3) { transpose_item(a.in[I_WSC] + (size_t)l * 256 * DM, DM, nullptr, (bf16_t*)(ws + WS_WBR), DM, 768, scr, r, lane); continue; } r -= I3;
        if (r < I4) { transpose_item(a.in[I_WOUT] + (size_t)l * DM * DM, DM, nullptr, (bf16_t*)(ws + WS_WOUT), DM, 0, scr, r, lane); continue; } r -= I4;
        if (r < I5) { transpose_item(a.in[I_WFFI] + (size_t)l * DM * 2 * DFF, 2 * DFF, a.in[I_NFG] + l * DM, (bf16_t*)(ws + WS_WFFI), DM, 0, scr, r, lane); continue; } r -= I5;
        transpose_item(a.in[I_WFFO] + (size_t)l * DFF * DM, DM, nullptr, (bf16_t*)(ws + WS_WFFO), DFF, 0, scr, r, lane);
    }
    {
        LAS float* xs = (LAS float*)(lds + wave * 16384);
        const float* xsrc = (l == 0 ? a.in[I_X] : a.out);
        float* part = (float*)(ws + WS_PART);
        if ((gw & 3) == 0)
        for (int it = gw >> 2; it < 512; it += (NGW + 3) >> 2) {
            const int cg = it & 15, kc = it >> 4, k0 = kc * 32;
            { const f32x4* xr = (const f32x4*)(xsrc + ((size_t)(lane >> 3) * SEQ + (lane & 7)) * DM + k0);
#pragma unroll
              for (int i = 0; i < 8; ++i) { const f32x4 v = xr[i]; *(LAS f32x4*)(xs + lane * 36 + 4 * i) = v; } }
            float w[32];
            { const float* Wl = a.in[I_WIN] + (size_t)l * DM * INW + (size_t)k0 * INW + 1536 + cg * 64 + lane; const float* gm = a.in[I_NMG] + l * DM + k0;
#pragma unroll
              for (int kk = 0; kk < 32; ++kk) w[kk] = Wl[(size_t)kk * INW] * gm[kk]; }
            LDS_WAIT(); asm volatile("" ::: "memory");
#pragma unroll 4
            for (int r = 0; r < 64; ++r) { float acc = 0.f;
#pragma unroll
                for (int k4 = 0; k4 < 8; ++k4) { const f32x4 xv = *(const LAS f32x4*)(xs + r * 36 + 4 * k4); acc += xv.x * w[4 * k4] + xv.y * w[4 * k4 + 1] + xv.z * w[4 * k4 + 2] + xv.w * w[4 * k4 + 3]; }
                part[((size_t)kc * 64 + r) * 1024 + cg * 64 + lane] = acc; }
            LDS_WAIT(); asm volatile("" ::: "memory");
        }
    }
    const int gt = bx * NTHR + tid, NGT = G * NTHR;
    if (l == 0) {
        float* ct = (float*)(ws + WS_ROT); float* st = ct + 4096 * 32;
        for (int e = gt; e < 4096 * 32; e += NGT) {
            const int pos = e >> 5, i = e & 31;
            const float inv = exp2f(-(float)i * 0.41524101186092029f);
            const float ang = (float)pos * inv;
            const float kq = rintf(ang * 0.15915494309189535f);
            float rr = fmaf(-kq, 6.28125f, ang); rr = fmaf(-kq, 0.0019353071795864769f, rr);
            const float rev = rr * 0.15915494309189535f;
            ct[e] = __builtin_amdgcn_cosf(rev); st[e] = __builtin_amdgcn_sinf(rev);
        }
        float* bt = (float*)(ws + WS_BT);
        if (gt < 512) { const int h = gt >> 7, d = gt & 127; const float* rb = a.in[I_RELB];
            bt[gt] = (rb[rel_bucket(d) * 4 + h] - rb[31 * 4 + h]) * LOG2E; }
    }
    if (gt == 0) {
        const float* lp = a.in[I_LAM] + l * 256; float s1 = 0.f, s2 = 0.f;
        for (int i = 0; i < 64; ++i) { s1 += lp[i] * lp[64 + i]; s2 += lp[128 + i] * lp[192 + i]; }
        ((float*)(ws + WS_LAM))[l] = expf(s1) - expf(s2) + (0.8f - 0.6f * expf(-0.3f * (float)l));
    }
    if (l == 0) xpass(a.in[I_X], (bf16_t*)(ws + WS_XB), (float*)(ws + WS_SSQ), gw, NGW, lane);
}

__device__ __forceinline__ void reduce_hx(unsigned char* ws, const int tid, const int bx, const int G) {
    const f32x4* part = (const f32x4*)(ws + WS_PART); f32x4* hx = (f32x4*)(ws + WS_HX);
    for (int e = bx * NTHR + tid; e < 64 * 1024 / 4; e += G * NTHR) { f32x4 s = (f32x4){0.f, 0.f, 0.f, 0.f};
#pragma unroll 16
        for (int kc = 0; kc < 32; ++kc) s += part[(size_t)kc * 16384 + e];
        hx[e] = s; }
}

#include <hip/hip_bf16.h>
#include <cmath>
namespace attn_body {
using bf16=__hip_bfloat16;
using bf16x8=__attribute__((ext_vector_type(8)))short;
using s16x4=__attribute__((ext_vector_type(4)))short;
using f32x16=__attribute__((ext_vector_type(16)))float;
using u32x4=__attribute__((ext_vector_type(4)))unsigned;
constexpr int SEQ=4096,D=64,QP=512,KP=512,VP=512,OP=1024;
constexpr int NW=8,QBLK=32,QB=QBLK*NW,KVBLK=64,NQB=SEQ/QB;
__device__ __forceinline__ int crow(int r,int hi){return (r&3)+8*(r>>2)+4*hi;}
#define SBAR() __builtin_amdgcn_sched_barrier(0)
__device__ __forceinline__ void cmask(f32x16&p0,f32x16&p1,int jb,int qrel,int hi){
  const float NEG=-INFINITY; int kb=64*jb+4*hi;
  #pragma unroll
  for(int r=0;r<16;++r){int kv=kb+(r&3)+8*(r>>2); if(kv>qrel)p0[r]=NEG; if(kv+32>qrel)p1[r]=NEG;}
}

typedef __attribute__((address_space(3))) const float* lds_fptr;
__device__ __forceinline__ void biasmask(f32x16&p0,f32x16&p1,int jb,int qrel,int hi,lds_fptr Tl){
  const float NEG=-INFINITY; const int d00=qrel-(64*jb+4*hi);
  #pragma unroll
  for(int g=0;g<4;++g){
    #pragma unroll
    for(int q=0;q<4;++q){const int r=4*g+q; const int d0=d00-(q+8*g),d1=d0-32;
      const int i0=d0<0?0:(d0>127?127:d0),i1=d1<0?0:(d1>127?127:d1);
      const float b0=Tl[i0],b1=Tl[i1];
      p0[r]=d0<0?NEG:p0[r]+b0; p1[r]=d1<0?NEG:p1[r]+b1;}
    __builtin_amdgcn_sched_barrier(0);
  }
}

__device__ __forceinline__ void fillneg(f32x16&p0,f32x16&p1){
  #pragma unroll
  for(int r=0;r<16;++r){p0[r]=-INFINITY;p1[r]=-INFINITY;}
}
constexpr int NSLOT=3, SLOTB=8192;
constexpr int LDS_K=0, LDS_V=NSLOT*SLOTB, LDS_WS=2*NSLOT*SLOTB, LDS_OST=LDS_WS+NW*64*4, LDS_BT=LDS_OST+NW*4096, LDS_BYTES=LDS_BT+512;
constexpr float C2=0.125f*1.4426950408889634f;
__device__ __forceinline__ void glds16(const void*gsrc,unsigned lds_dst){unsigned keep;
  asm volatile("s_mov_b32 %0, m0\n\ts_mov_b32 m0, %2\n\ts_nop 0\n\tglobal_load_lds_dwordx4 %1, off\n\ts_mov_b32 m0, %0":"=&s"(keep):"v"(gsrc),"s"(lds_dst):"memory");}
__device__ __forceinline__ float max3f(float a,float b,float c){float r;asm("v_max3_f32 %0, %1, %2, %3":"=v"(r):"v"(a),"v"(b),"v"(c));return r;}
__device__ __forceinline__ float max2f(float a,float b){float r;asm("v_max_f32_e32 %0, %1, %2":"=v"(r):"v"(a),"v"(b));return r;}
__device__ __forceinline__ float fadd_s(float a,float b){float r;asm("v_add_f32_e32 %0, %1, %2":"=v"(r):"v"(a),"v"(b));return r;}
__device__ __forceinline__ float fsub_s(float a,float b){float r;asm("v_sub_f32_e32 %0, %1, %2":"=v"(r):"v"(a),"v"(b));return r;}
typedef float f32x2_t __attribute__((ext_vector_type(2))); typedef __bf16 bf16x2_t __attribute__((ext_vector_type(2)));
__device__ __forceinline__ unsigned cvtpk_s(float lo,float hi){f32x2_t v={lo,hi};bf16x2_t b=__builtin_convertvector(v,bf16x2_t);return __builtin_bit_cast(unsigned,b);}
#define WAIT_BAR(N) asm volatile("s_waitcnt vmcnt(" #N ") lgkmcnt(0)\n\ts_barrier":::"memory")

__device__ __forceinline__ void qkt(f32x16&p0,f32x16&p1,const char*Kslot,const bf16x8*qr,const f32x16&negm,int r32,int hi){
  const char*kb=Kslot+hi*1024+r32*16;
  #pragma unroll
  for(int d0=0;d0<4;++d0){
    const bf16x8 b0=*reinterpret_cast<const bf16x8*>(kb+d0*2048);
    const bf16x8 b1=*reinterpret_cast<const bf16x8*>(kb+d0*2048+512);
    if(d0==0){p0=__builtin_amdgcn_mfma_f32_32x32x16_bf16(b0,qr[0],negm,0,0,0);p1=__builtin_amdgcn_mfma_f32_32x32x16_bf16(b1,qr[0],negm,0,0,0);}
    else{p0=__builtin_amdgcn_mfma_f32_32x32x16_bf16(b0,qr[d0],p0,0,0,0);p1=__builtin_amdgcn_mfma_f32_32x32x16_bf16(b1,qr[d0],p1,0,0,0);}}
}
typedef __attribute__((address_space(3))) const char* lds_cptr;
typedef short v4i16_t __attribute__((ext_vector_type(4)));
__device__ __forceinline__ void kload8(bf16x8*kf,lds_cptr kp){
  kf[0]=*(const __attribute__((address_space(3))) bf16x8*)(kp);      kf[1]=*(const __attribute__((address_space(3))) bf16x8*)(kp+512);
  kf[2]=*(const __attribute__((address_space(3))) bf16x8*)(kp+2048); kf[3]=*(const __attribute__((address_space(3))) bf16x8*)(kp+2560);
  kf[4]=*(const __attribute__((address_space(3))) bf16x8*)(kp+4096); kf[5]=*(const __attribute__((address_space(3))) bf16x8*)(kp+4608);
  kf[6]=*(const __attribute__((address_space(3))) bf16x8*)(kp+6144); kf[7]=*(const __attribute__((address_space(3))) bf16x8*)(kp+6656);
}
__device__ __forceinline__ void kload2(bf16x8*kf,lds_cptr kp,int j){ kf[2*j]=*(const __attribute__((address_space(3))) bf16x8*)(kp+j*2048); kf[2*j+1]=*(const __attribute__((address_space(3))) bf16x8*)(kp+j*2048+512); }
__device__ __forceinline__ s16x4 vtr(lds_cptr p){ return __builtin_bit_cast(s16x4,__builtin_amdgcn_ds_read_tr16_b64_v4i16((__attribute__((address_space(3))) v4i16_t*)p)); }
__device__ __forceinline__ float rowmax(const f32x16&p0,const f32x16&p1){
  float a=max3f(p0[0],p0[1],p1[0]),b=max3f(p0[2],p0[3],p1[1]);a=max3f(a,p1[2],p1[3]);
  #pragma unroll
  for(int r=4;r<16;r+=4){a=max3f(a,p0[r],p0[r+1]);b=max3f(b,p0[r+2],p0[r+3]);a=max3f(a,p1[r],p1[r+1]);b=max3f(b,p1[r+2],p1[r+3]);}
  const float m=max2f(a,b);
  auto rr=__builtin_amdgcn_permlane32_swap(__float_as_uint(m),__float_as_uint(m),false,false);
  return max2f(__uint_as_float(rr[0]),__uint_as_float(rr[1]));
}
__device__ __forceinline__ void pv(f32x16*o,int vb,bf16x8 pa0,bf16x8 pa1,bf16x8 pa2,bf16x8 pa3){
  #pragma unroll
  for(int d0=0;d0<2;++d0){s16x4 lo[4],hi[4];
    #pragma unroll
    for(int ks=0;ks<4;++ks){
      asm volatile("ds_read_b64_tr_b16 %0,%1 offset:%c2":"=&v"(lo[ks]):"v"(vb),"i"(d0*4096+ks*1024):"memory");
      asm volatile("ds_read_b64_tr_b16 %0,%1 offset:%c2":"=&v"(hi[ks]):"v"(vb),"i"(d0*4096+ks*1024+512):"memory");}
    asm volatile("s_waitcnt lgkmcnt(0)":::"memory");SBAR();
    #define PK(k) (bf16x8){lo[k][0],lo[k][1],lo[k][2],lo[k][3],hi[k][0],hi[k][1],hi[k][2],hi[k][3]}
    o[d0]=__builtin_amdgcn_mfma_f32_32x32x16_bf16(pa0,PK(0),o[d0],0,0,0);
    o[d0]=__builtin_amdgcn_mfma_f32_32x32x16_bf16(pa1,PK(1),o[d0],0,0,0);
    o[d0]=__builtin_amdgcn_mfma_f32_32x32x16_bf16(pa2,PK(2),o[d0],0,0,0);
    o[d0]=__builtin_amdgcn_mfma_f32_32x32x16_bf16(pa3,PK(3),o[d0],0,0,0);
    #undef PK
  }
}

#ifndef ATTN_STORE16
#define ATTN_STORE16(p,v) (*(u32x4*)(p)=(v))
#endif
template<int THRL> __device__ __forceinline__ void attn_unit(int qb,const bf16*Qb,const bf16*__restrict__ Kh,const bf16*__restrict__ Vh,bf16*Ob,const float*BTg,char*shm,const int tid){
  const int lane=tid&63,r32=lane&31,hi=lane>>5; const int wid=__builtin_amdgcn_readfirstlane(tid>>6);
  const int q0=qb*QB;
  const bf16*Qw=Qb+(long)(q0+wid*QBLK)*QP;
  int tl_=tid; asm volatile("":"+v"(tl_)); float btv_=0.f; if(tl_<128)btv_=BTg[tl_];
  const lds_fptr Tl=(lds_fptr)((lds_cptr)shm+LDS_BT);
  const unsigned lds0=(unsigned)(uintptr_t)shm;
  float*wsf=(float*)(shm+LDS_WS)+wid*64;
  const bf16*ksrc=Kh+(long)lane*KP+wid*8;
  const bf16*vsrc=Vh+(long)(16*(wid&3)+(lane>>2))*VP+(wid>>2)*32+(lane&3)*8;
  const unsigned kdst=lds0+LDS_K+wid*1024, vdst=lds0+LDS_V+wid*1024;
  #define DMA_K(t,slot) glds16(ksrc+(long)(t)*KVBLK*KP,(unsigned)__builtin_amdgcn_readfirstlane(kdst+(slot)))
  #define DMA_V(t,slot) glds16(vsrc+(long)(t)*KVBLK*VP,(unsigned)__builtin_amdgcn_readfirstlane(vdst+(slot)))
  const int vb0=(int)(lds0+LDS_V)+((lane>>4)&1)*32+(lane&3)*8+(4*hi+((lane&15)>>2))*64;
  const char*Kbase=shm+LDS_K; bf16x8 kf[8];
  const lds_cptr shm3=(lds_cptr)shm; const lds_cptr kp0=shm3+LDS_K+hi*1024+r32*16; const lds_cptr vp0=shm3+LDS_V+((lane>>4)&1)*32+(lane&3)*8+(4*hi+((lane&15)>>2))*64;
  const int NT=(q0+QB)/KVBLK;
  DMA_K(0,0);DMA_V(0,0);DMA_K(1,SLOTB);
  bf16x8 qr[4];
  #pragma unroll
  for(int d0=0;d0<4;++d0)qr[d0]=*reinterpret_cast<const bf16x8*>(&Qw[(long)r32*QP+d0*16+hi*8]);
  float zz_=0.f;asm volatile("":"+v"(zz_));
  float mhat=zz_,l_reg=zz_;f32x16 o[2],negm;
  _Pragma("unroll") for(int r=0;r<16;++r){o[0][r]=zz_;o[1][r]=zz_;negm[r]=zz_;} asm volatile("":"+v"(negm));
  const int qrel=wid*QBLK+r32;
  #define CMASK(P0,P1,t) do{int jb_=(t)-(NT-4); if(64*jb_+176>32*wid)biasmask(P0,P1,jb_,qrel,hi,Tl); }while(0)
  bool resc=false;
  #define START(P0,P1) do{ const float rm=rowmax(P0,P1); resc=false; \
    { const float dl=rm; mhat=fadd_s(mhat,dl); \
      _Pragma("unroll") for(int r=0;r<16;++r){P0[r]=fsub_s(P0[r],dl);P1[r]=fsub_s(P1[r],dl);} \
      _Pragma("unroll") for(int r=0;r<16;++r)negm[r]=-mhat; asm volatile("":"+v"(negm)); } \
    _Pragma("unroll") for(int r=0;r<16;++r)P0[r]=__builtin_amdgcn_exp2f(P0[r]); }while(0)
  #define RESC() do{ if(resc){ asm volatile("s_waitcnt lgkmcnt(0)":::"memory"); \
      _Pragma("unroll") for(int d_=0;d_<2;++d_) _Pragma("unroll") for(int r=0;r<16;++r)o[d_][r]*=wsf[crow(r,hi)]; } }while(0)
  f32x16 pA0,pA1,pB0,pB1;
  int sl_prev=0,sl_cur=0,sl_next=SLOTB;
  #define ROT() do{sl_prev=sl_cur;sl_cur=sl_next;sl_next=(sl_next==(NSLOT-1)*SLOTB)?0:sl_next+SLOTB;}while(0)
  { float*tw=(float*)(shm+LDS_BT); if(tl_<128)tw[tl_]=btv_; }
  DMA_K(2,2*SLOTB);
  WAIT_BAR(3);
  qkt(pA0,pA1,Kbase,qr,negm,r32,hi);asm volatile("s_nop 15\n\ts_nop 7":"+v"(pA0),"+v"(pA1));CMASK(pA0,pA1,0);
  START(pA0,pA1);
  _Pragma("unroll") for(int r=0;r<16;++r)pA1[r]=__builtin_amdgcn_exp2f(pA1[r]);
  WAIT_BAR(0);
  DMA_K(3,0);DMA_V(1,SLOTB);
  ROT();
  kload8(kf,kp0+sl_cur);
  WAIT_BAR(2);
  s16x4 vlo[8],vhi[8]; u32x4 pw0,pw1,pw2,pw3;
  #define PKW(P,B) cvtpk_s(P[B],P[B+1])
  #define PAF(k) __builtin_bit_cast(bf16x8,pw##k)
  #define VFR(i) (bf16x8){vlo[i][0],vlo[i][1],vlo[i][2],vlo[i][3],vhi[i][0],vhi[i][1],vhi[i][2],vhi[i][3]}
  #define PIN(x) asm volatile("":"+v"(x))
  #define MX3(a,b,c) __builtin_fmaxf(__builtin_fmaxf((a),(b)),(c))
  #define GAPA(MF,A0,A1,A2,A3,W0,W1,PW) do{ MF; sacc+=A0; sacc+=A1; sacc+=A2; sacc+=A3; PIN(sacc); W0; W1; PIN(PW); SBAR(); }while(0)
  #define EX(v) __builtin_amdgcn_exp2f(v)
  #define GAPB(MF,X,B) do{ MF; X[B]=EX(X[B]); X[B+1]=EX(X[B+1]); X[B+2]=EX(X[B+2]); X[B+3]=EX(X[B+3]); PIN(X); SBAR(); }while(0)
  #define VRD(i) do{ vlo[i]=vtr(vp_+(((i)>>2)*4096+((i)&3)*1024)); vhi[i]=vtr(vp_+(((i)>>2)*4096+((i)&3)*1024+512)); }while(0)
  #define KRD(G,j) do{ if(G){ kload2(kf,kp0+sl_next,j); SBAR(); } }while(0)
  #define STEP(C0,C1,P0,P1,t,GK,GV,GL) do{ SBAR(); \
    const lds_cptr vp_=vp0+sl_prev; \
    VRD(0); SBAR(); float sacc=(P0[0]+P0[1]); \
    GAPA(C0=__builtin_amdgcn_mfma_f32_32x32x16_bf16(kf[0],qr[0],negm,0,0,0), P0[2],P0[3],P0[4],P0[5],     pw0[0]=PKW(P0,0), pw0[1]=PKW(P0,2), pw0); \
    VRD(4); SBAR(); GAPA(C1=__builtin_amdgcn_mfma_f32_32x32x16_bf16(kf[1],qr[0],negm,0,0,0), P0[6],P0[7],P0[8],P0[9],     pw0[2]=PKW(P0,4), pw0[3]=PKW(P0,6), pw0); \
    VRD(1); SBAR(); GAPA(C0=__builtin_amdgcn_mfma_f32_32x32x16_bf16(kf[2],qr[1],C0,0,0,0),   P0[10],P0[11],P0[12],P0[13], pw1[0]=PKW(P0,8), pw1[1]=PKW(P0,10), pw1); \
    VRD(5); SBAR(); GAPA(C1=__builtin_amdgcn_mfma_f32_32x32x16_bf16(kf[3],qr[1],C1,0,0,0),   P0[14],P0[15],P1[0],P1[1],   pw1[2]=PKW(P0,12),pw1[3]=PKW(P0,14), pw1); \
    VRD(2); SBAR(); GAPA(C0=__builtin_amdgcn_mfma_f32_32x32x16_bf16(kf[4],qr[2],C0,0,0,0),   P1[2],P1[3],P1[4],P1[5],     pw2[0]=PKW(P1,0), pw2[1]=PKW(P1,2), pw2); \
    VRD(6); SBAR(); GAPA(C1=__builtin_amdgcn_mfma_f32_32x32x16_bf16(kf[5],qr[2],C1,0,0,0),   P1[6],P1[7],P1[8],P1[9],     pw2[2]=PKW(P1,4), pw2[3]=PKW(P1,6), pw2); \
    VRD(3); SBAR(); GAPA(C0=__builtin_amdgcn_mfma_f32_32x32x16_bf16(kf[6],qr[3],C0,0,0,0),   P1[10],P1[11],P1[12],P1[13], pw3[0]=PKW(P1,8), pw3[1]=PKW(P1,10), pw3); \
    VRD(7); SBAR(); GAPA(C1=__builtin_amdgcn_mfma_f32_32x32x16_bf16(kf[7],qr[3],C1,0,0,0),   P1[14],P1[15],0.f,0.f,       pw3[2]=PKW(P1,12),pw3[3]=PKW(P1,14), pw3); \
    l_reg+=sacc; \
    if(GK){DMA_K((t)+3,sl_cur);} if(GV){DMA_V((t)+1,sl_next);} \
    CMASK(C0,C1,t); \
    { float a=MX3(C0[0],C0[1],C1[0]),b=MX3(C0[2],C0[3],C1[1]); a=MX3(a,C1[2],C1[3]); \
      _Pragma("unroll") for(int r=4;r<16;r+=4){a=MX3(a,C0[r],C0[r+1]);b=MX3(b,C0[r+2],C0[r+3]);a=MX3(a,C1[r],C1[r+1]);b=MX3(b,C1[r+2],C1[r+3]);} \
      float rm=__builtin_fmaxf(a,b); { auto rr=__builtin_amdgcn_permlane32_swap(__float_as_uint(rm),__float_as_uint(rm),false,false); rm=__builtin_fmaxf(__uint_as_float(rr[0]),__uint_as_float(rr[1])); } \
      resc=false; \
      if(__builtin_expect(__any(rm>(float)THRL),0)){ const float dl=__builtin_fmaxf(rm,0.f); mhat+=dl; \
        _Pragma("unroll") for(int r=0;r<16;++r){C0[r]-=dl;C1[r]-=dl;} \
        _Pragma("unroll") for(int r=0;r<16;++r)negm[r]=-mhat; asm volatile("":"+v"(negm)); \
        const float f=__builtin_amdgcn_exp2f(-dl); l_reg*=f; if(hi==0)wsf[r32]=f; resc=true; } } \
    SBAR(); \
    GAPB(o[0]=__builtin_amdgcn_mfma_f32_32x32x16_bf16(PAF(0),VFR(0),o[0],0,0,0), C0,0); \
    GAPB(o[1]=__builtin_amdgcn_mfma_f32_32x32x16_bf16(PAF(0),VFR(4),o[1],0,0,0), C0,4); \
    KRD(GL,0); GAPB(o[0]=__builtin_amdgcn_mfma_f32_32x32x16_bf16(PAF(1),VFR(1),o[0],0,0,0), C0,8); \
    KRD(GL,1); GAPB(o[1]=__builtin_amdgcn_mfma_f32_32x32x16_bf16(PAF(1),VFR(5),o[1],0,0,0), C0,12); \
    KRD(GL,2); GAPB(o[0]=__builtin_amdgcn_mfma_f32_32x32x16_bf16(PAF(2),VFR(2),o[0],0,0,0), C1,0); \
    KRD(GL,3); GAPB(o[1]=__builtin_amdgcn_mfma_f32_32x32x16_bf16(PAF(2),VFR(6),o[1],0,0,0), C1,4); \
    GAPB(o[0]=__builtin_amdgcn_mfma_f32_32x32x16_bf16(PAF(3),VFR(3),o[0],0,0,0), C1,8); \
    GAPB(o[1]=__builtin_amdgcn_mfma_f32_32x32x16_bf16(PAF(3),VFR(7),o[1],0,0,0), C1,12); \
    }while(0)
  int t=1;
  #undef CMASK
  #define CMASK(P0,P1,t) do{}while(0)
  for(;t+7<NT;t+=2){
    STEP(pB0,pB1,pA0,pA1,t,true,true,true);     WAIT_BAR(2); RESC(); ROT();
    STEP(pA0,pA1,pB0,pB1,t+1,true,true,true);   WAIT_BAR(2); RESC(); ROT();
  }
  #undef CMASK
  #define CMASK(P0,P1,t) do{int jb_=(t)-(NT-4); if(64*jb_+176>32*wid)biasmask(P0,P1,jb_,qrel,hi,Tl); }while(0)
  #define ENDW(tt) do{ if((tt)+3<NT){WAIT_BAR(2);} else if((tt)+2<NT){WAIT_BAR(1);} else {WAIT_BAR(0);} }while(0)
  for(;t+1<NT;t+=2){
    STEP(pB0,pB1,pA0,pA1,t,(t+3<NT),(t+1<NT),(t+1<NT));       ENDW(t);   RESC(); ROT();
    STEP(pA0,pA1,pB0,pB1,t+1,(t+4<NT),(t+2<NT),(t+2<NT));     ENDW(t+1); RESC(); ROT();
  }
  STEP(pB0,pB1,pA0,pA1,NT-1,false,false,false); RESC();
  { float sacc=pB0[0]+pB0[1]; _Pragma("unroll") for(int r=2;r<16;++r)sacc+=pB0[r]; _Pragma("unroll") for(int r=0;r<16;++r)sacc+=pB1[r]; l_reg+=sacc;
    pw0=(u32x4){PKW(pB0,0),PKW(pB0,2),PKW(pB0,4),PKW(pB0,6)};pw1=(u32x4){PKW(pB0,8),PKW(pB0,10),PKW(pB0,12),PKW(pB0,14)};pw2=(u32x4){PKW(pB1,0),PKW(pB1,2),PKW(pB1,4),PKW(pB1,6)};pw3=(u32x4){PKW(pB1,8),PKW(pB1,10),PKW(pB1,12),PKW(pB1,14)};
    SBAR(); pv(o,vb0+sl_cur,PAF(0),PAF(1),PAF(2),PAF(3)); }
  #undef PKW
  #undef PAF
  #undef VFR
  #undef PIN
  #undef MX3
  #undef GAPA
  #undef GAPB
  #undef EX
  #undef VRD
  #undef KRD
  #undef STEP
  #undef ENDW
  {auto rr=__builtin_amdgcn_permlane32_swap(__float_as_uint(l_reg),__float_as_uint(l_reg),false,false);l_reg=__uint_as_float(rr[0])+__uint_as_float(rr[1]);}
  if(hi==0)wsf[32+r32]=l_reg;asm volatile("s_waitcnt lgkmcnt(0)":::"memory");
  float rli[16];
  #pragma unroll
  for(int r=0;r<16;++r)rli[r]=__builtin_amdgcn_rcpf(wsf[32+crow(r,hi)]);
  bf16*Ow=Ob+(long)(q0+wid*QBLK)*OP;
  { bf16*stg=(bf16*)(shm+LDS_OST)+wid*2048;
    #pragma unroll
    for(int r=0;r<16;++r){const int orow=crow(r,hi);
      #pragma unroll
      for(int d0=0;d0<2;++d0)stg[orow*64+d0*32+r32]=__float2bfloat16(o[d0][r]*rli[r]);}
    asm volatile("s_waitcnt lgkmcnt(0)":::"memory");
    #pragma unroll
    for(int i=0;i<4;++i){const int row=i*8+(lane>>3),ch=lane&7; const u32x4 v=*(const u32x4*)(stg+row*64+ch*8); ATTN_STORE16(Ow+(long)row*OP+ch*8,v);} }
  asm volatile("s_waitcnt lgkmcnt(0)\n\ts_barrier":::"memory");
  #undef DMA_K
  #undef DMA_V
  #undef CMASK
  #undef START
  #undef RESC
  #undef ROT
}
constexpr int ATTN_LDS_BYTES=LDS_BYTES;
#undef SBAR
#undef WAIT_BAR
}

namespace fa3 {
constexpr int KP = 72;
typedef float f32x2_t __attribute__((ext_vector_type(2))); typedef __bf16 bf16x2_t __attribute__((ext_vector_type(2)));
__device__ __forceinline__ unsigned cvtpk(float lo, float hi) { f32x2_t v = {lo, hi}; bf16x2_t b = __builtin_convertvector(v, bf16x2_t); return __builtin_bit_cast(unsigned, b); }
__device__ __forceinline__ void unit(unsigned char* ws, LAS unsigned char* lds, int b, int h, int mp, int qb, const int tid_in) {
    int tid = tid_in; asm volatile("" : "+v"(tid));
    const int lane = tid & 63, w = __builtin_amdgcn_readfirstlane(tid >> 6), fr = lane & 15, fq = lane >> 4;
    const bf16_t* Q = (const bf16_t*)(ws + WS_R + R_Q) + (size_t)b * SEQ * 512 + (h * 2 + mp) * 64;
    const bf16_t* K = (const bf16_t*)(ws + WS_R + R_K) + (size_t)b * SEQ * 512 + (h * 2 + mp) * 64;
    const bf16_t* V = (const bf16_t*)(ws + WS_R + R_V) + (size_t)b * SEQ * 512 + h * 128;
    bf16_t* O = (bf16_t*)(ws + WS_XB) + (size_t)b * SEQ * 1024 + h * 256 + mp * 128;
    const float* BTg = (const float*)(ws + WS_BT) + h * 128;
    constexpr int KVB = (64 + 128) * KP;
    LAS bf16_t* KV0 = (LAS bf16_t*)lds; LAS float* TB = (LAS float*)(KV0 + 2 * KVB);
    const int q0 = qb * 256, qw0 = q0 + 32 * w, NT = 4 * qb + 4;
    __syncthreads();
    { const int d_ = tid - 256; TB[tid] = d_ < 0 ? -INFINITY : (d_ < 128 ? BTg[d_] : 0.f); }
    bf16x8 qf[2][2];
#pragma unroll
    for (int g = 0; g < 2; ++g) { const bf16_t* qp = Q + (size_t)(qw0 + 16 * g + fr) * 512 + 8 * fq; qf[g][0] = *(const bf16x8*)qp; qf[g][1] = *(const bf16x8*)(qp + 32); }
    float m[2] = {0.f, 0.f}; f32x4 lacc[2] = {(f32x4){0.f, 0.f, 0.f, 0.f}, (f32x4){0.f, 0.f, 0.f, 0.f}}; f32x4 o[2][8];
    const bf16x8 onesf = {0x3F80, 0x3F80, 0x3F80, 0x3F80, 0x3F80, 0x3F80, 0x3F80, 0x3F80};
#pragma unroll
    for (int g = 0; g < 2; ++g)
#pragma unroll
        for (int et = 0; et < 8; ++et) o[g][et] = (f32x4){0.f, 0.f, 0.f, 0.f};
    const int sr = tid >> 3, sc = tid & 7;
    const bf16_t* kg = K + (size_t)sr * 512 + sc * 8;
    const int vp = tid >> 4, vc = tid & 15;
    const bf16_t* vg = V + (size_t)(2 * vp) * 512 + vc * 8;
    u32x4 kA = *(const u32x4*)kg, vA0 = *(const u32x4*)vg, vA1 = *(const u32x4*)(vg + 512);
    u32x4 kB = *(const u32x4*)(kg + (size_t)64 * 512), vB0 = *(const u32x4*)(vg + (size_t)64 * 512), vB1 = *(const u32x4*)(vg + (size_t)64 * 512 + 512);
#define FA3_STAGE(BUF) do { LAS bf16_t* ks_ = KV0 + (BUF) * KVB; LAS bf16_t* vt_ = ks_ + 64 * KP; *(LAS u32x4*)(ks_ + sr * KP + sc * 8) = kA; \
        const unsigned va_[4] = {vA0.x, vA0.y, vA0.z, vA0.w}, vb_[4] = {vA1.x, vA1.y, vA1.z, vA1.w}; const int k2_ = 2 * vp; \
        const int col_ = ((k2_ & 32) + 8 * ((k2_ >> 2) & 3) + 4 * ((k2_ >> 4) & 1) + (k2_ & 3) + 8 * (vc >> 1)) & 63;     \
        _Pragma("unroll") for (int w_ = 0; w_ < 4; ++w_) { *(LAS unsigned*)(vt_ + (vc * 8 + 2 * w_) * KP + col_) = (va_[w_] & 0xffffu) | (vb_[w_] << 16); \
            *(LAS unsigned*)(vt_ + (vc * 8 + 2 * w_ + 1) * KP + col_) = (va_[w_] >> 16) | (vb_[w_] & 0xffff0000u); } } while (0)
    FA3_STAGE(0);
    kA = kB; vA0 = vB0; vA1 = vB1;
    { const size_t off = (size_t)2 * 64 * 512; kB = *(const u32x4*)(kg + off); vB0 = *(const u32x4*)(vg + off); vB1 = *(const u32x4*)(vg + off + 512); }
    __syncthreads();
    for (int kt = 0; kt < NT; ++kt) {
        LAS bf16_t* KS = KV0 + (kt & 1) * KVB; LAS bf16_t* VT = KS + 64 * KP;
        const int k0 = kt * 64;
        if (k0 <= qw0 + 31) {
        f32x4 s[2][4];
#pragma unroll
        for (int jt = 0; jt < 4; ++jt) { const bf16x8 kf0 = *(const LAS bf16x8*)(KS + (16 * jt + fr) * KP + 8 * fq), kf1 = *(const LAS bf16x8*)(KS + (16 * jt + fr) * KP + 32 + 8 * fq);
#pragma unroll
            for (int g = 0; g < 2; ++g) { const float nm = -m[g]; s[g][jt] = __builtin_amdgcn_mfma_f32_16x16x32_bf16(kf0, qf[g][0], (f32x4){nm, nm, nm, nm}, 0, 0, 0); s[g][jt] = __builtin_amdgcn_mfma_f32_16x16x32_bf16(kf1, qf[g][1], s[g][jt], 0, 0, 0); } }
        const bool nearb = (qw0 - (k0 + 63) < 113);
        bf16x8 pf[2][2];
#pragma unroll
        for (int g = 0; g < 2; ++g) {
            if (nearb) {
                const LAS float* tb = TB + (256 + qw0 + 16 * g + fr - (k0 + 4 * fq));
#pragma unroll
                for (int jt = 0; jt < 4; ++jt)
#pragma unroll
                    for (int jj = 0; jj < 4; ++jj) { const float bv = tb[-(16 * jt + jj)]; float x = s[g][jt][jj];
                        asm("v_add_f32_e32 %0, %1, %2" : "=v"(x) : "v"(x), "v"(bv));
                        s[g][jt][jj] = x; }
            }
            float mx = fmaxf(fmaxf(s[g][0][0], s[g][0][1]), fmaxf(s[g][0][2], s[g][0][3]));
#pragma unroll
            for (int jt = 1; jt < 4; ++jt) mx = fmaxf(mx, fmaxf(fmaxf(s[g][jt][0], s[g][jt][1]), fmaxf(s[g][jt][2], s[g][jt][3])));
            if (__any(mx > 8.f)) {
                mx = fmaxf(mx, __shfl_xor(mx, 16)); mx = fmaxf(mx, __shfl_xor(mx, 32));
                const float dl = fmaxf(mx, 0.f), alpha = __builtin_amdgcn_exp2f(-dl);
                m[g] += dl; lacc[g] *= alpha;
#pragma unroll
                for (int jt = 0; jt < 4; ++jt) s[g][jt] -= dl;
#pragma unroll
                for (int et = 0; et < 8; ++et) o[g][et] *= alpha;
            }
#pragma unroll
            for (int jt = 0; jt < 4; ++jt) {
#pragma unroll
                for (int jj = 0; jj < 4; ++jj) s[g][jt][jj] = __builtin_amdgcn_exp2f(s[g][jt][jj]); }
#pragma unroll
            for (int sb = 0; sb < 2; ++sb) { u32x4 pw; pw.x = cvtpk(s[g][2 * sb][0], s[g][2 * sb][1]); pw.y = cvtpk(s[g][2 * sb][2], s[g][2 * sb][3]); pw.z = cvtpk(s[g][2 * sb + 1][0], s[g][2 * sb + 1][1]); pw.w = cvtpk(s[g][2 * sb + 1][2], s[g][2 * sb + 1][3]);
                pf[g][sb] = __builtin_bit_cast(bf16x8, pw); }
        }
#pragma unroll
        for (int g = 0; g < 2; ++g) {
            lacc[g] = __builtin_amdgcn_mfma_f32_16x16x32_bf16(onesf, pf[g][0], lacc[g], 0, 0, 0); lacc[g] = __builtin_amdgcn_mfma_f32_16x16x32_bf16(onesf, pf[g][1], lacc[g], 0, 0, 0); }
#pragma unroll
        for (int et = 0; et < 8; ++et) { const LAS bf16_t* vrow = VT + (16 * et + fr) * KP;
            const bf16x8 vf0 = *(const LAS bf16x8*)(vrow + ((8 * fq + 8 * et) & 63)), vf1 = *(const LAS bf16x8*)(vrow + ((32 + 8 * fq + 8 * et) & 63));
#pragma unroll
            for (int g = 0; g < 2; ++g) { o[g][et] = __builtin_amdgcn_mfma_f32_16x16x32_bf16(vf0, pf[g][0], o[g][et], 0, 0, 0); o[g][et] = __builtin_amdgcn_mfma_f32_16x16x32_bf16(vf1, pf[g][1], o[g][et], 0, 0, 0); } }
        }
        if (kt + 1 < NT) { FA3_STAGE((kt + 1) & 1); kA = kB; vA0 = vB0; vA1 = vB1;
            if (kt + 3 < NT) { const size_t off = (size_t)(kt + 3) * 64 * 512; kB = *(const u32x4*)(kg + off); vB0 = *(const u32x4*)(vg + off); vB1 = *(const u32x4*)(vg + off + 512); } }
        __syncthreads();
    }
#pragma unroll
    for (int g = 0; g < 2; ++g) {
        const float il = __builtin_amdgcn_rcpf(lacc[g][0]);
#pragma unroll
        for (int et = 0; et < 8; ++et) { u32x2 ow; ow.x = cvtpk(o[g][et][0] * il, o[g][et][1] * il); ow.y = cvtpk(o[g][et][2] * il, o[g][et][3] * il);
            *(u32x2*)(O + (size_t)(qw0 + 16 * g + fr) * 1024 + 16 * et + 4 * fq) = ow; }
    }
}
#undef FA3_STAGE
}

constexpr int RP64 = 72, RP128 = 136;
__device__ __forceinline__ void retkv_unit(unsigned char* ws, LAS unsigned char* lds, int u, const int tid) {
    const int b = u >> 7, h = (u >> 5) & 3, n = u & 31;
    const int lane = tid & 63, w = __builtin_amdgcn_readfirstlane(tid >> 6), fr = lane & 15, fq = lane >> 4;
    const bf16_t* RK = (const bf16_t*)(ws + WS_R + R_RK); const bf16_t* RV = (const bf16_t*)(ws + WS_R + R_RV);
    const float lg2 = log2f(1.f - exp2f(-5.f - (float)h));
    const size_t row0 = (size_t)b * SEQ + n * 128;
    LAS bf16_t* VT = (LAS bf16_t*)lds; LAS bf16_t* KT = VT + 64 * RP128;
    __syncthreads();
    { const int r = tid >> 2, c0 = (tid & 3) * 16;
      const u32x4* vs = (const u32x4*)(RV + (row0 + r) * 256 + h * 64 + c0); const u32x4 a0 = vs[0], a1 = vs[1];
      const u32x4* ksrc = (const u32x4*)(RK + (row0 + r) * 256 + h * 64 + c0); const u32x4 k0 = ksrc[0], k1 = ksrc[1];
      const unsigned vw[8] = {a0.x, a0.y, a0.z, a0.w, a1.x, a1.y, a1.z, a1.w}; const unsigned kw[8] = {k0.x, k0.y, k0.z, k0.w, k1.x, k1.y, k1.z, k1.w};
      const float dec = exp2f(lg2 * (float)(127 - r));
#pragma unroll
      for (int i = 0; i < 8; ++i) { VT[(c0 + 2 * i) * RP128 + r] = (bf16_t)(vw[i] & 0xffffu); VT[(c0 + 2 * i + 1) * RP128 + r] = (bf16_t)(vw[i] >> 16);
          const unsigned kp = cvt_pk_bf16(bflo(kw[i]) * dec, bfhi(kw[i]) * dec);
          KT[(c0 + 2 * i) * RP128 + r] = (bf16_t)(kp & 0xffffu); KT[(c0 + 2 * i + 1) * RP128 + r] = (bf16_t)(kp >> 16); } }
    __syncthreads();
    const int et = w >> 1;
#pragma unroll
    for (int t2 = 0; t2 < 2; ++t2) { const int dt = (w & 1) * 2 + t2; f32x4 acc = (f32x4){0.f, 0.f, 0.f, 0.f};
#pragma unroll
        for (int sb = 0; sb < 4; ++sb) { const bf16x8 kf = *(const LAS bf16x8*)(KT + (16 * dt + fr) * RP128 + 32 * sb + 8 * fq); const bf16x8 vf = *(const LAS bf16x8*)(VT + (16 * et + fr) * RP128 + 32 * sb + 8 * fq);
            acc = __builtin_amdgcn_mfma_f32_16x16x32_bf16(kf, vf, acc, 0, 0, 0); }
        u32x2 o; o.x = cvt_pk_bf16(acc[0], acc[1]); o.y = cvt_pk_bf16(acc[2], acc[3]);
        *(u32x2*)((bf16_t*)(ws + WS_KV) + (size_t)u * 4096 + (16 * et + fr) * 64 + 16 * dt + 4 * fq) = o; }
}
typedef float f32x2_c __attribute__((ext_vector_type(2))); typedef __bf16 bf16x2_c __attribute__((ext_vector_type(2)));
__device__ __forceinline__ unsigned cvtpk_c(float lo, float hi) { f32x2_c v = {lo, hi}; bf16x2_c b = __builtin_convertvector(v, bf16x2_c); return __builtin_bit_cast(unsigned, b); }
__device__ __forceinline__ void retkv_mfma_unit(unsigned char* ws, LAS unsigned char* lds, int u, const int tid) {
    const int b = u >> 7, h = (u >> 5) & 3, n = u & 31;
    const int lane = tid & 63, w = __builtin_amdgcn_readfirstlane(tid >> 6), fr = lane & 15, fq = lane >> 4;
    const bf16_t* RK = (const bf16_t*)(ws + WS_R + R_RK); const bf16_t* RV = (const bf16_t*)(ws + WS_R + R_RV);
    const float lg2 = log2f(1.f - exp2f(-5.f - (float)h));
    const size_t row0 = (size_t)b * SEQ + n * 128;
    LAS bf16_t* VT = (LAS bf16_t*)lds; LAS bf16_t* KT = VT + 64 * RP128;
    __syncthreads();
    { const int r = tid >> 2, c0 = (tid & 3) * 16;
      const u32x4* vs = (const u32x4*)(RV + (row0 + r) * 256 + h * 64 + c0); const u32x4 a0 = vs[0], a1 = vs[1];
      const u32x4* ksrc = (const u32x4*)(RK + (row0 + r) * 256 + h * 64 + c0); const u32x4 k0 = ksrc[0], k1 = ksrc[1];
      const unsigned vw[8] = {a0.x, a0.y, a0.z, a0.w, a1.x, a1.y, a1.z, a1.w}; const unsigned kw[8] = {k0.x, k0.y, k0.z, k0.w, k1.x, k1.y, k1.z, k1.w};
      const float dec = exp2f(lg2 * (float)(127 - r));
#pragma unroll
      for (int i = 0; i < 8; ++i) { VT[(c0 + 2 * i) * RP128 + r] = (bf16_t)(vw[i] & 0xffffu); VT[(c0 + 2 * i + 1) * RP128 + r] = (bf16_t)(vw[i] >> 16);
          const unsigned kp = cvt_pk_bf16(bflo(kw[i]) * dec, bfhi(kw[i]) * dec);
          KT[(c0 + 2 * i) * RP128 + r] = (bf16_t)(kp & 0xffffu); KT[(c0 + 2 * i + 1) * RP128 + r] = (bf16_t)(kp >> 16); } }
    __syncthreads();
    const int et = w >> 1;
#pragma unroll
    for (int t2 = 0; t2 < 2; ++t2) { const int dt = (w & 1) * 2 + t2; f32x4 acc = (f32x4){0.f, 0.f, 0.f, 0.f};
#pragma unroll
        for (int sb = 0; sb < 4; ++sb) { const bf16x8 kf = *(const LAS bf16x8*)(KT + (16 * dt + fr) * RP128 + 32 * sb + 8 * fq); const bf16x8 vf = *(const LAS bf16x8*)(VT + (16 * et + fr) * RP128 + 32 * sb + 8 * fq);
            acc = __builtin_amdgcn_mfma_f32_16x16x32_bf16(kf, vf, acc, 0, 0, 0); }
        u32x2 o; o.x = cvtpk_c(acc[0], acc[1]); o.y = cvtpk_c(acc[2], acc[3]);
        *(u32x2*)((bf16_t*)(ws + WS_KV) + (size_t)u * 4096 + (16 * et + fr) * 64 + 16 * dt + 4 * fq) = o; }
}
__device__ __forceinline__ void retkv_naive_unit(unsigned char* ws, unsigned char* lds, int u, const int tid) {
    const int b = u >> 7, h = (u >> 5) & 3, n = u & 31;
    const bf16_t* RK = (const bf16_t*)(ws + WS_R + R_RK); const bf16_t* RV = (const bf16_t*)(ws + WS_R + R_RV);
    const float lg2 = log2f(1.f - exp2f(-5.f - (float)h));
    const size_t row0 = (size_t)b * SEQ + n * 128;
    bf16_t* KS = (bf16_t*)lds; bf16_t* VS = KS + 128 * 72;
    __syncthreads();
    { const int r = tid >> 2, c0 = (tid & 3) * 16;
      const u32x4* ksrc = (const u32x4*)(RK + (row0 + r) * 256 + h * 64 + c0); const u32x4 k0 = ksrc[0], k1 = ksrc[1];
      const u32x4* vsrc = (const u32x4*)(RV + (row0 + r) * 256 + h * 64 + c0); const u32x4 v0 = vsrc[0], v1 = vsrc[1];
      *(u32x4*)(KS + r * 72 + c0) = k0; *(u32x4*)(KS + r * 72 + c0 + 8) = k1; *(u32x4*)(VS + r * 72 + c0) = v0; *(u32x4*)(VS + r * 72 + c0 + 8) = v1; }
    __syncthreads();
    const int d = tid >> 3, eg = tid & 7;
    float av[8];
#pragma unroll
    for (int i = 0; i < 8; ++i) av[i] = 0.f;
#pragma unroll 8
    for (int c = 0; c < 128; ++c) {
        const float kd = bf2f(KS[c * 72 + d]) * exp2f(lg2 * (float)(127 - c));
        const u32x4 v = *(const u32x4*)(VS + c * 72 + eg * 8);
        av[0] += kd * bflo(v.x); av[1] += kd * bfhi(v.x); av[2] += kd * bflo(v.y); av[3] += kd * bfhi(v.y);
        av[4] += kd * bflo(v.z); av[5] += kd * bfhi(v.z); av[6] += kd * bflo(v.w); av[7] += kd * bfhi(v.w);
    }
#pragma unroll
    for (int i = 0; i < 8; ++i) ((bf16_t*)(ws + WS_KV))[(size_t)u * 4096 + (eg * 8 + i) * 64 + d] = (bf16_t)(cvt_pk_bf16(av[i], 0.f) & 0xffffu);
}
__device__ __forceinline__ void phase_B1(CArgs& a, int l, unsigned char* lds, const int tid, const int bx, const int G) {
    {
        for (int vc = bx; vc < 256; vc += G) {
            const int vcu = (G == 256) ? ((vc & 7) * 32 + (vc >> 3)) : vc;
            const int combo = vcu >> 2, s = vcu & 3;
            const int b = combo >> 3, h = (combo >> 1) & 3, mp = combo & 1;
            for (int i = 0; i < 4; ++i) { const int qb = (i == 0) ? s : (i == 1) ? 7 - s : (i == 2) ? 8 + s : 15 - s; fa3::unit(a.ws, (LAS unsigned char*)lds, b, h, mp, qb, tid); }
        }
    }
    { int tid2 = tid; asm volatile("" : "+v"(tid2)); for (int u = bx; u < 1024; u += G) retkv_mfma_unit(a.ws, (LAS unsigned char*)lds, u, tid2); }
}

__device__ __forceinline__ void retout_unit(CArgs& a, int l, unsigned char* lds, int u, const int tid) {
    unsigned char* ws = a.ws;
    const int b = u >> 7, h = (u >> 5) & 3, n = u & 31;
    const int lane = tid & 63, w = __builtin_amdgcn_readfirstlane(tid >> 6), fr = lane & 15, fq = lane >> 4;
    const bf16_t* RQ = (const bf16_t*)(ws + WS_R + R_RQ); const bf16_t* RK = (const bf16_t*)(ws + WS_R + R_RK); const bf16_t* RV = (const bf16_t*)(ws + WS_R + R_RV);
    const bf16_t* RG = (const bf16_t*)(ws + WS_R + R_RG); const bf16_t* KV = (const bf16_t*)(ws + WS_KV);
    bf16_t* OC = (bf16_t*)(ws + WS_R + R_OCAT);
    const float lg2 = log2f(1.f - exp2f(-5.f - (float)h));
    const size_t row0 = (size_t)b * SEQ + n * 128;
    LAS bf16_t* KS = (LAS bf16_t*)lds; LAS bf16_t* VT = KS + 128 * RP64; LAS bf16_t* RT = VT + 64 * RP128; LAS bf16_t* PS = RT + 64 * RP64;
    __syncthreads();
    { const int r = tid >> 2, c0 = (tid & 3) * 16;
      const u32x4* ksrc = (const u32x4*)(RK + (row0 + r) * 256 + h * 64 + c0); const u32x4 k0 = ksrc[0], k1 = ksrc[1];
      *(LAS u32x4*)(KS + r * RP64 + c0) = k0; *(LAS u32x4*)(KS + r * RP64 + c0 + 8) = k1;
      const u32x4* vs = (const u32x4*)(RV + (row0 + r) * 256 + h * 64 + c0); const u32x4 a0 = vs[0], a1 = vs[1];
      const unsigned vw[8] = {a0.x, a0.y, a0.z, a0.w, a1.x, a1.y, a1.z, a1.w};
#pragma unroll
      for (int i = 0; i < 8; ++i) { VT[(c0 + 2 * i) * RP128 + r] = (bf16_t)(vw[i] & 0xffffu); VT[(c0 + 2 * i + 1) * RP128 + r] = (bf16_t)(vw[i] >> 16); } }
    { float r[8];
#pragma unroll
      for (int i = 0; i < 8; ++i) r[i] = 0.f;
#pragma unroll 8
      for (int m = 0; m < n; ++m) { const float wgt = exp2f(lg2 * 128.f * (float)(n - 1 - m)); const u32x4 v = *(const u32x4*)(KV + (size_t)(u - n + m) * 4096 + tid * 8);
          r[0] += wgt * bflo(v.x); r[1] += wgt * bfhi(v.x); r[2] += wgt * bflo(v.y); r[3] += wgt * bfhi(v.y); r[4] += wgt * bflo(v.z); r[5] += wgt * bfhi(v.z); r[6] += wgt * bflo(v.w); r[7] += wgt * bfhi(v.w); }
      u32x4 o; o.x = cvt_pk_bf16(r[0], r[1]); o.y = cvt_pk_bf16(r[2], r[3]); o.z = cvt_pk_bf16(r[4], r[5]); o.w = cvt_pk_bf16(r[6], r[7]);
      *(LAS u32x4*)(RT + (tid >> 3) * RP64 + (tid & 7) * 8) = o; }
    const int c = 16 * w + fr; const size_t row = row0 + c;
    const bf16x8 qf0 = *(const bf16x8*)(RQ + row * 256 + h * 64 + 8 * fq), qf1 = *(const bf16x8*)(RQ + row * 256 + h * 64 + 32 + 8 * fq);
    __syncthreads();
    for (int jt = 0; jt <= w; ++jt) {
        f32x4 s = (f32x4){0.f, 0.f, 0.f, 0.f};
        const bf16x8 kf0 = *(const LAS bf16x8*)(KS + (16 * jt + fr) * RP64 + 8 * fq), kf1 = *(const LAS bf16x8*)(KS + (16 * jt + fr) * RP64 + 32 + 8 * fq);
        s = __builtin_amdgcn_mfma_f32_16x16x32_bf16(kf0, qf0, s, 0, 0, 0); s = __builtin_amdgcn_mfma_f32_16x16x32_bf16(kf1, qf1, s, 0, 0, 0);
        const int dj0 = c - (16 * jt + 4 * fq); float p[4];
#pragma unroll
        for (int jj = 0; jj < 4; ++jj) { const int dj = dj0 - jj; p[jj] = dj >= 0 ? s[jj] * exp2f(lg2 * (float)dj) : 0.f; }
        u32x2 pw; pw.x = cvt_pk_bf16(p[0], p[1]); pw.y = cvt_pk_bf16(p[2], p[3]);
        *(LAS u32x2*)(PS + c * RP128 + 16 * jt + 4 * fq) = pw;
    }
    if (!(w & 1)) { unsigned zq = 0u; asm volatile("" : "+v"(zq)); u32x2 z; z.x = zq; z.y = zq; *(LAS u32x2*)(PS + c * RP128 + 16 * (w + 1) + 4 * fq) = z; }
    LDS_WAIT(); asm volatile("" ::: "memory");
    f32x4 o[4], x[4];
#pragma unroll
    for (int et = 0; et < 4; ++et) { o[et] = (f32x4){0.f, 0.f, 0.f, 0.f}; x[et] = (f32x4){0.f, 0.f, 0.f, 0.f}; }
    for (int sb = 0; sb <= (w >> 1); ++sb) {
        const bf16x8 pf = *(const LAS bf16x8*)(PS + c * RP128 + 32 * sb + 8 * fq);
#pragma unroll
        for (int et = 0; et < 4; ++et) { const bf16x8 vf = *(const LAS bf16x8*)(VT + (16 * et + fr) * RP128 + 32 * sb + 8 * fq); o[et] = __builtin_amdgcn_mfma_f32_16x16x32_bf16(vf, pf, o[et], 0, 0, 0); }
    }
#pragma unroll
    for (int et = 0; et < 4; ++et) { const bf16x8 r0 = *(const LAS bf16x8*)(RT + (16 * et + fr) * RP64 + 8 * fq), r1 = *(const LAS bf16x8*)(RT + (16 * et + fr) * RP64 + 32 + 8 * fq);
        x[et] = __builtin_amdgcn_mfma_f32_16x16x32_bf16(r0, qf0, x[et], 0, 0, 0); x[et] = __builtin_amdgcn_mfma_f32_16x16x32_bf16(r1, qf1, x[et], 0, 0, 0); }
    const float qd = exp2f(lg2 * (float)(c + 1));
    float ss = 0.f;
#pragma unroll
    for (int et = 0; et < 4; ++et) { o[et] += x[et] * qd; ss += (o[et][0] * o[et][0] + o[et][1] * o[et][1]) + (o[et][2] * o[et][2] + o[et][3] * o[et][3]); }
    ss += __shfl_xor(ss, 16); ss += __shfl_xor(ss, 32);
    const float ri = rsqrtf(ss * (1.f / 64.f) + EPS);
    const bool head_rows = (n == 0 && c < 8);
#pragma unroll
    for (int et = 0; et < 4; ++et) { const int e0 = 16 * et + 4 * fq;
        const u32x2 gw = *(const u32x2*)(RG + row * 256 + h * 64 + e0); const f32x4 gg = *(const f32x4*)(a.in[I_RETG] + l * 64 + e0);
        u32x2 ow; ow.x = cvt_pk_bf16(o[et][0] * ri * gg[0] * bflo(gw.x), o[et][1] * ri * gg[1] * bfhi(gw.x)); ow.y = cvt_pk_bf16(o[et][2] * ri * gg[2] * bflo(gw.y), o[et][3] * ri * gg[3] * bfhi(gw.y));
        if (!head_rows) *(u32x2*)(OC + row * 1024 + 512 + h * 64 + e0) = ow; }
    if (n == 0) {
        __syncthreads();
        float* pr = (float*)lds;
        { const float* hx = (const float*)(ws + WS_HX); const float* ssqv = (const float*)(ws + WS_SSQ);
#pragma unroll
          for (int i = 0; i < 4; ++i) { const int e = tid + i * 512, t = e >> 8, cc = e & 255;
              pr[e] = hx[(size_t)(b * 8 + t) * 1024 + (cc >> 6) * 256 + h * 64 + (cc & 63)] * row_scale(ssqv, b * SEQ + t); } }
        __syncthreads();
        { const int t = tid >> 6, i = tid & 31, isk = (tid >> 5) & 1; float* p = pr + t * 256 + isk * 64;
          const float* ctb = (const float*)(ws + WS_ROT); const float cs = ctb[t * 32 + i], sn = ctb[4096 * 32 + t * 32 + i];
          const float x1 = p[i], x2 = p[i + 32], sc = isk ? 0.125f : 1.f;
          p[i] = (x1 * cs - x2 * sn) * sc; p[i + 32] = (x2 * cs + x1 * sn) * sc; }
        __syncthreads();
        { const int t = tid >> 6, e = tid & 63; float o = 0.f;
          for (int j = 0; j <= t; ++j) { float d = 0.f;
              for (int dd = 0; dd < 64; ++dd) d += pr[t * 256 + dd] * pr[j * 256 + 64 + dd];
              o += d * exp2f(lg2 * (float)(t - j)) * pr[j * 256 + 128 + e]; }
          const float ss2 = wave_sum(o * o); const float ri2 = rsqrtf(ss2 * (1.f / 64.f) + EPS);
          const float gv = pr[t * 256 + 192 + e];
          const float val = o * ri2 * a.in[I_RETG][l * 64 + e] * gv * sigmoidf_(gv);
          OC[((size_t)b * SEQ + t) * 1024 + 512 + h * 64 + e] = (bf16_t)(cvt_pk_bf16(val, 0.f) & 0xffffu); }
    }
}
__device__ __forceinline__ void phase_B2(CArgs& a, int l, unsigned char* lds, const int tid, const int bx, const int G) {
    unsigned char* ws = a.ws; unsigned char* R = ws + WS_R;
    const int lane = tid & 63, wave = tid >> 6;
    const int gw = bx * NWAVES + wave, NGW = G * NWAVES;
    for (int up = bx; up < 1024; up += G) { const int u = (up & ~31) | ((up + 8 * (up >> 8)) & 31);
        retout_unit(a, l, lds, u, tid); }
    const float lam = ((const float*)(ws + WS_LAM))[l];
    const float post = 1.f - (0.8f - 0.6f * expf(-0.3f * (float)l));
    const bf16_t* OR = (const bf16_t*)(ws + WS_XB); bf16_t* OC = (bf16_t*)(R + R_OCAT);
    const bf16_t* SB = (const bf16_t*)(R + R_SCB); const bf16_t* SC = (const bf16_t*)(R + R_SCC); const bf16_t* SX = (const bf16_t*)(R + R_SCX);
#pragma unroll 4
    for (int row = gw; row < MT; row += NGW) {
        {
            const int h = lane >> 4, e0 = (lane & 15) * 8;
            const u32x4 w0 = *(const u32x4*)(OR + (size_t)row * 1024 + h * 256 + e0), w1 = *(const u32x4*)(OR + (size_t)row * 1024 + h * 256 + 128 + e0);
            float v[8] = {bflo(w0.x) - lam * bflo(w1.x), bfhi(w0.x) - lam * bfhi(w1.x), bflo(w0.y) - lam * bflo(w1.y), bfhi(w0.y) - lam * bfhi(w1.y),
                          bflo(w0.z) - lam * bflo(w1.z), bfhi(w0.z) - lam * bfhi(w1.z), bflo(w0.w) - lam * bflo(w1.w), bfhi(w0.w) - lam * bfhi(w1.w)};
            float s = 0.f;
#pragma unroll
            for (int i = 0; i < 8; ++i) s += v[i] * v[i];
            s += __shfl_xor(s, 1); s += __shfl_xor(s, 2); s += __shfl_xor(s, 4); s += __shfl_xor(s, 8);
            const float r = rsqrtf(s * (1.f / 128.f) + EPS) * post; const float* g = a.in[I_SUBLN] + l * 128 + e0;
            u32x4 o; o.x = cvt_pk_bf16(v[0] * r * g[0], v[1] * r * g[1]); o.y = cvt_pk_bf16(v[2] * r * g[2], v[3] * r * g[3]);
            o.z = cvt_pk_bf16(v[4] * r * g[4], v[5] * r * g[5]); o.w = cvt_pk_bf16(v[6] * r * g[6], v[7] * r * g[7]);
            *(u32x4*)(OC + (size_t)row * 1024 + h * 128 + e0) = o;
        }
        if (lane < 32) {
            const int ch = lane * 8, pos = row & (SEQ - 1);
            const float* cw = a.in[I_SCW] + l * 3 * 256 + ch; const float* cb = a.in[I_SCB] + l * 256 + ch;
            float y[8];
#pragma unroll
            for (int i = 0; i < 8; ++i) y[i] = cb[i];
#pragma unroll
            for (int k = 0; k < 3; ++k) { const int dt = 2 - k; if (pos >= dt) {
                const u32x4 cv = *(const u32x4*)(SC + (size_t)(row - dt) * 256 + ch), xv = *(const u32x4*)(SX + (size_t)(row - dt) * 256 + ch); const float* w = cw + k * 256;
                y[0] += w[0] * bflo(cv.x) * bflo(xv.x); y[1] += w[1] * bfhi(cv.x) * bfhi(xv.x); y[2] += w[2] * bflo(cv.y) * bflo(xv.y); y[3] += w[3] * bfhi(cv.y) * bfhi(xv.y);
                y[4] += w[4] * bflo(cv.z) * bflo(xv.z); y[5] += w[5] * bfhi(cv.z) * bfhi(xv.z); y[6] += w[6] * bflo(cv.w) * bflo(xv.w); y[7] += w[7] * bfhi(cv.w) * bfhi(xv.w); } }
            const u32x4 bv = *(const u32x4*)(SB + (size_t)row * 256 + ch);
            u32x4 o; o.x = cvt_pk_bf16(y[0] * bflo(bv.x), y[1] * bfhi(bv.x)); o.y = cvt_pk_bf16(y[2] * bflo(bv.y), y[3] * bfhi(bv.y));
            o.z = cvt_pk_bf16(y[4] * bflo(bv.z), y[5] * bfhi(bv.z)); o.w = cvt_pk_bf16(y[6] * bflo(bv.w), y[7] * bfhi(bv.w));
            *(u32x4*)(OC + (size_t)row * 1024 + 768 + ch) = o;
        }
    }
}

__device__ __forceinline__ void phase_F(CArgs& a, int l, const int tid, const int bx, const int G) {
    unsigned char* R = a.ws + WS_R;
    const bf16_t* Gb = (const bf16_t*)(R + R_G); bf16_t* U = (bf16_t*)(R + R_U);
    const int gt = bx * NTHR + tid, NGT = G * NTHR;
    constexpr int CPR = DFF / 8, SEGR = 32, NSEG = MT / SEGR;
    for (int it = gt; it < NSEG * CPR; it += NGT) {
        const int seg = it / CPR, ch = (it - seg * CPR) * 8, row0 = seg * SEGR;
        const float* cw = a.in[I_FCW] + (size_t)l * 3 * DFF + ch; const float* cbp = a.in[I_FCB] + (size_t)l * DFF + ch;
        const f32x4 w0a = *(const f32x4*)(cw), w0b = *(const f32x4*)(cw + 4), w1a = *(const f32x4*)(cw + DFF), w1b = *(const f32x4*)(cw + DFF + 4), w2a = *(const f32x4*)(cw + 2 * DFF), w2b = *(const f32x4*)(cw + 2 * DFF + 4);
        const f32x4 cba = *(const f32x4*)(cbp), cbb = *(const f32x4*)(cbp + 4);
        u32x4 gm2 = (u32x4){0u, 0u, 0u, 0u}, gm1 = (u32x4){0u, 0u, 0u, 0u};
        if ((row0 & (SEQ - 1)) != 0) { gm2 = *(const u32x4*)(Gb + (size_t)(row0 - 2) * DFF + ch); gm1 = *(const u32x4*)(Gb + (size_t)(row0 - 1) * DFF + ch); }
#pragma unroll 4
        for (int r = 0; r < SEGR; ++r) {
            const size_t off = (size_t)(row0 + r) * DFF + ch;
            const u32x4 g0 = *(const u32x4*)(Gb + off); const u32x4 uv = *(const u32x4*)(U + off);
            f32x4 ya = cba, yb = cbb;
            ya += w0a * (f32x4){bflo(gm2.x), bfhi(gm2.x), bflo(gm2.y), bfhi(gm2.y)}; yb += w0b * (f32x4){bflo(gm2.z), bfhi(gm2.z), bflo(gm2.w), bfhi(gm2.w)};
            ya += w1a * (f32x4){bflo(gm1.x), bfhi(gm1.x), bflo(gm1.y), bfhi(gm1.y)}; yb += w1b * (f32x4){bflo(gm1.z), bfhi(gm1.z), bflo(gm1.w), bfhi(gm1.w)};
            ya += w2a * (f32x4){bflo(g0.x), bfhi(g0.x), bflo(g0.y), bfhi(g0.y)};     yb += w2b * (f32x4){bflo(g0.z), bfhi(g0.z), bflo(g0.w), bfhi(g0.w)};
#pragma unroll
            for (int i = 0; i < 4; ++i) { ya[i] = ya[i] * sigmoidf_(ya[i]); yb[i] = yb[i] * sigmoidf_(yb[i]); }
            u32x4 o; o.x = cvt_pk_bf16(ya[0] * bflo(uv.x), ya[1] * bfhi(uv.x)); o.y = cvt_pk_bf16(ya[2] * bflo(uv.y), ya[3] * bfhi(uv.y));
            o.z = cvt_pk_bf16(yb[0] * bflo(uv.z), yb[1] * bfhi(uv.z)); o.w = cvt_pk_bf16(yb[2] * bflo(uv.w), yb[3] * bfhi(uv.w));
            *(u32x4*)(U + off) = o;
            gm2 = gm1; gm1 = g0;
        }
    }
}
constexpr int PH_PER_LAYER = 9, NPH = PH_PER_LAYER * DEPTH;
__global__ void __launch_bounds__(NTHR, 2) mk_fwd(Args a_by_value) {
    extern __shared__ __attribute__((aligned(16))) unsigned char lds[];
    LAS unsigned char* ldsl = (LAS unsigned char*)lds;
    const int ph_lo = a_by_value.ph_lo, ph_hi = a_by_value.ph_hi;
    const int wave_s = __builtin_amdgcn_readfirstlane((int)threadIdx.x >> 6);
#define PHASE_ENTER(k) int tid, wv_ = wave_s, bx = blockIdx.x, G = gridDim.x, l = lq; CArgs* ka = (CArgs*)__builtin_amdgcn_kernarg_segment_ptr(); \
        asm volatile("; phase " #k "\n\tv_mbcnt_lo_u32_b32 %0, -1, 0\n\tv_mbcnt_hi_u32_b32 %0, -1, %0\n\tv_lshl_or_b32 %0, %1, 6, %0" : "=&v"(tid), "+s"(wv_), "+s"(l), "+s"(bx), "+s"(G), "+s"(ka)); CArgs& a = *ka; unsigned char* ws = a.ws; unsigned char* R = ws + WS_R; (void)R; (void)G; (void)bx; (void)tid
    for (int ph = ph_lo; ph < ph_hi; ++ph) {
        int lq = ph / PH_PER_LAYER, p = ph - lq * PH_PER_LAYER;
        asm volatile("" : "+s"(lq), "+s"(p));
        if (p == 0) { PHASE_ENTER(0); phase_W(a, l, ldsl, tid, bx, G); }
        else if (p == 1) {
            PHASE_ENTER(1);
            reduce_hx(ws, tid, bx, G);
            pg8::Gemm g{(const bf16_t*)(ws + WS_XB), (const bf16_t*)(ws + WS_WIN), DM}; pg8::Order S; S.init(MT, INW, G, bx, 1, DM / 64);
            EpiSplit<0> E{R, (const float*)(ws + WS_SSQ), a.in[I_BGATE] + l * 3072, a.in[I_QG] + l * 64, a.in[I_KG] + l * 64, (const float*)(ws + WS_ROT)};
            pg8::gemm_phase(ldsl, g, S, E, tid);
        }
        else if (p == 2) { PHASE_ENTER(2); phase_B1(a, l, lds, tid, bx, G); }
        else if (p == 3) { PHASE_ENTER(3); phase_B2(a, l, lds, tid, bx, G); }
        else if (p == 4) {
            PHASE_ENTER(4);
            pg8::Gemm g{(const bf16_t*)(R + R_OCAT), (const bf16_t*)(ws + WS_WBR), DM}; pg8::Order S; S.init(MT, DM, G, bx, 1, DM / 64);
            EpiAcc E{(const bf16_t*)(R + R_GATES), (bf16_t*)(R + R_Y)};
            pg8::gemm_phase(ldsl, g, S, E, tid);
        }
        else if (p == 5) {
            PHASE_ENTER(5);
            pg8::Gemm g{(const bf16_t*)(R + R_Y), (const bf16_t*)(ws + WS_WOUT), DM}; pg8::Order S; S.init(MT, DM, G, bx, 1, DM / 64);
            EpiRes E{l == 0 ? a.in[I_X] : a.out, a.out, (bf16_t*)(ws + WS_XB), (float*)(ws + WS_SSQ)};
            pg8::gemm_phase(ldsl, g, S, E, tid);
        }
        else if (p == 6) {
            PHASE_ENTER(6);
            pg8::Gemm g{(const bf16_t*)(ws + WS_XB), (const bf16_t*)(ws + WS_WFFI), DM}; pg8::Order S; S.init(MT, 2 * DFF, G, bx, 1, DM / 64);
            EpiSplit<1> E{R, (const float*)(ws + WS_SSQ), nullptr, nullptr, nullptr, nullptr};
            pg8::gemm_phase(ldsl, g, S, E, tid);
        }
        else if (p == 7) { PHASE_ENTER(7); phase_F(a, l, tid, bx, G); }
        else {
            PHASE_ENTER(8);
            pg8::Gemm g{(const bf16_t*)(R + R_U), (const bf16_t*)(ws + WS_WFFO), DFF}; pg8::Order S; S.init(MT, DM, G, bx, 1, DFF / 64);
            EpiRes E{a.out, a.out, (bf16_t*)(ws + WS_XB), (float*)(ws + WS_SSQ)};
            pg8::gemm_phase(ldsl, g, S, E, tid);
        }
        if (ph + 1 < ph_hi) cg::this_grid().sync();
    }
}

extern "C" void kernel_launch(void* const* d_in, const int* in_sizes, int n_in, void* d_out, int out_size, void* d_ws, size_t ws_size, hipStream_t stream) {
    static int grid = 0;
    if (grid == 0) {
        if (n_in != 21 || out_size != MT * DM || ws_size < WS_END) { fprintf(stderr, "kernel_launch: unexpected problem (n_in %d out %d ws %zu)\n", n_in, out_size, ws_size); grid = -1; return; }
        int dev = 0, cus = 0;
        hipGetDevice(&dev); hipDeviceGetAttribute(&cus, hipDeviceAttributeMultiprocessorCount, dev);
        if (hipFuncSetAttribute((const void*)mk_fwd, hipFuncAttributeMaxDynamicSharedMemorySize, LDS_BYTES) != hipSuccess) { fprintf(stderr, "kernel_launch: hipFuncSetAttribute failed\n"); grid = -1; return; }
        int per_cu = 0;
        if (hipOccupancyMaxActiveBlocksPerMultiprocessor(&per_cu, (const void*)mk_fwd, NTHR, LDS_BYTES) != hipSuccess || per_cu < 1) fprintf(stderr, "kernel_launch: occupancy query says %d\n", per_cu);
        (void)hipGetLastError();
        grid = cus > 0 ? cus : 256;
    }
    if (grid < 0) return;
    Args a{};
    for (int i = 0; i < 21; ++i) a.in[i] = (const float*)d_in[i];
    a.out = (float*)d_out; a.ws = (unsigned char*)d_ws;
#if MK_ONE_LAUNCH
    a.ph_lo = 0; a.ph_hi = NPH;
    void* args[] = {&a};
    hipError_t e = hipLaunchCooperativeKernel((const void*)mk_fwd, dim3(grid), dim3(NTHR), args, LDS_BYTES, stream);
    if (e != hipSuccess) fprintf(stderr, "cooperative launch failed: %s (grid %d)\n", hipGetErrorString(e), grid);
#else
    for (int ph = 0; ph < NPH; ++ph) {
        a.ph_lo = ph; a.ph_hi = ph + 1;
        hipLaunchKernelGGL(mk_fwd, dim3(grid), dim3(NTHR), LDS_BYTES, stream, a);
    }
#endif
}
```

```cpp
#include <hip/hip_runtime.h>
#include <hip/hip_cooperative_groups.h>
#include <cstdio>
#include <cstdint>
namespace cg = cooperative_groups;

#ifndef MK_ONE_LAUNCH
#define MK_ONE_LAUNCH 1
#endif

#define LAS __attribute__((address_space(3)))
typedef unsigned short bf16_t;
typedef short bf16x8 __attribute__((ext_vector_type(8)));
typedef float f32x4 __attribute__((ext_vector_type(4)));
typedef unsigned u32x4 __attribute__((ext_vector_type(4)));
typedef unsigned u32x2 __attribute__((ext_vector_type(2)));

constexpr int NB = 8, SEQ = 4096, DM = 1024, MT = NB * SEQ, INW = 6400, DFF = 2816, DEPTH = 2;
constexpr float EPS = 1e-6f;
constexpr float LOG2E = 1.4426950408889634f;
constexpr float C2 = 0.125f * LOG2E;
constexpr int NWAVES = 8, NTHR = 512;
constexpr size_t MiB = 1u << 20;
constexpr size_t WS_ROT = 1 * MiB;
constexpr size_t WS_BT = 2 * MiB;
constexpr size_t WS_LAM = 2 * MiB + 4096;
constexpr size_t WS_RS = 3 * MiB;
constexpr size_t WS_WIN = 4 * MiB;
constexpr size_t WS_WBR = WS_WIN + (size_t)INW * DM * 2;
constexpr size_t WS_WOUT = WS_WBR + 2 * MiB;
constexpr size_t WS_WFFI = WS_WOUT + 2 * MiB;
constexpr size_t WS_WFFO = WS_WFFI + (size_t)2 * DFF * DM * 2;
constexpr size_t WS_XB = 38 * MiB;
constexpr size_t WS_R = 102 * MiB;
constexpr size_t R_Q = 0, R_K = 32 * MiB, R_V = 64 * MiB, R_RQ = 96 * MiB, R_RK = 112 * MiB, R_RV = 128 * MiB, R_RG = 144 * MiB,
                 R_SCB = 160 * MiB, R_SCC = 176 * MiB, R_SCX = 192 * MiB, R_GATES = 208 * MiB;
constexpr size_t R_OCAT = 0, R_Y = 64 * MiB, R_G = 0, R_U = 176 * MiB;
constexpr size_t WS_KV = 502 * MiB;
constexpr size_t WS_SSQ = 510 * MiB;
constexpr size_t WS_END = 512 * MiB;
constexpr size_t WS_HX = 256 * 1024;
constexpr size_t WS_PART = WS_KV;
static_assert(WS_WFFO + (size_t)DM * DFF * 2 <= WS_XB, "weights fit");

constexpr int LDS_BYTES = 147456;

#define LDS_WAIT() asm volatile("s_waitcnt lgkmcnt(0)" ::: "memory")

__device__ __forceinline__ unsigned cvt_pk_bf16(float lo, float hi) { unsigned r; asm volatile("v_cvt_pk_bf16_f32 %0, %1, %2" : "=v"(r) : "v"(lo), "v"(hi)); return r; }
__device__ __forceinline__ float bflo(unsigned w) { return __uint_as_float(w << 16); }
__device__ __forceinline__ float bfhi(unsigned w) { return __uint_as_float(w & 0xffff0000u); }
__device__ __forceinline__ float bf2f(bf16_t b) { return __uint_as_float((unsigned)b << 16); }
__device__ __forceinline__ float sigmoidf_(float v) { return __builtin_amdgcn_rcpf(1.f + __expf(-v)); }

__device__ __forceinline__ float row_scale(const float* ssq, int row) {
    const f32x4* p = (const f32x4*)(ssq + (size_t)row * 16); const f32x4 a = p[0], b = p[1], c = p[2], d = p[3];
    const float s = ((a.x + a.y) + (a.z + a.w)) + ((b.x + b.y) + (b.z + b.w)) + ((c.x + c.y) + (c.z + c.w)) + ((d.x + d.y) + (d.z + d.w));
    return rsqrtf(s * (1.f / DM) + EPS);
}

namespace pg8 {
constexpr int BM = 256, BK = 64, HALF = 128, HTB = HALF * BK * 2, STAGE_BYTES = 8 * HTB, NXCD = 8, WGM = 4;
__host__ __device__ __forceinline__ int lds_byte(int r, int c) { const int st = (r >> 4) * 2 + (c >> 5), rr = r & 15, cc = c & 31, ob = rr * 64 + cc * 2; return st * 1024 + (ob ^ (((ob >> 9) & 1) << 5)); }
__host__ __device__ __forceinline__ void stage_rc(int b, int& R, int& C) { const int st = b / 1024, sb = b % 1024, swz = sb ^ (((sb >> 9) & 1) << 5); R = (st >> 1) * 16 + swz / 64; C = (st & 1) * 32 + (swz % 64) / 2; }
__host__ __device__ __forceinline__ int perm32(int rho) { const int n = rho >> 4, i = rho & 15; return 8 * (i >> 2) + 4 * n + (i & 3); }

struct Unit { int pm, pn, koff, nt, seg; };
struct Gemm { const bf16_t* A; const bf16_t* Bt; int pitch; };

struct Order {
    int nM, nN, nwg, G, c, nseg, nt0, wgm;
    __device__ void init(int M, int N, int G_, int c_, int nseg_, int nt0_) { nM = M / BM; nN = N / BM; nwg = nM * nN; G = G_; c = c_; nseg = nseg_; nt0 = nt0_; wgm = (nN >= 8) ? 4 : 8; }
    __device__ bool next(int i, Unit& u) const {
        int tile = i, seg = 0;
        if (nseg == 3) { tile = i / 3; seg = i - tile * 3; }
        const long L = (long)tile * G + c; if (L >= nwg) return false;
        int wgid = (int)L; { const int q = nwg / NXCD, r = nwg % NXCD, xcd = wgid % NXCD, off = wgid / NXCD; wgid = (xcd < r ? xcd * (q + 1) : r * (q + 1) + (xcd - r) * q) + off; }
        const int nig = wgm * nN, gid = wgid / nig, fm = gid * wgm, gsz = (nM - fm) < wgm ? (nM - fm) : wgm;
        u.pm = fm + ((wgid % nig) % gsz); u.pn = (wgid % nig) / gsz; u.seg = seg;
        if (nseg == 3) { u.koff = seg == 0 ? 0 : (seg == 1 ? 512 : 768); u.nt = seg == 0 ? 8 : 4; }
        else { u.koff = 0; u.nt = nt0; }
        return true;
    }
};

template <class Epi, class Sched>
__device__ __forceinline__ void gemm_phase(LAS unsigned char* lds, const Gemm g, const Sched& S, const Epi& E, const int tid) {
    const int wid = __builtin_amdgcn_readfirstlane(tid >> 6), lane = tid & 63, wr = wid >> 2, wc = wid & 3, fr = lane & 15, fq = lane >> 4;
    const int P = g.pitch;
    unsigned voffA[2], voffB[2];
#pragma unroll
    for (int i = 0; i < 2; ++i) { int R, C; stage_rc(tid * 16 + i * 8192, R, C); const int Rb = Epi::PERM ? ((R & ~31) + perm32(R & 31)) : R;
        voffA[i] = (unsigned)(R * P + C) * 2u; voffB[i] = (unsigned)(Rb * P + C) * 2u; }
    const size_t kstep = (size_t)(BK * 2);
    const size_t hstep = (size_t)HALF * P * 2;
    const size_t tstep = 2 * hstep;
    const unsigned ldsw = (unsigned)wid * 1024u;
    const int aoff = lds_byte(wr * 64 + fr, fq * 8), boff = lds_byte(wc * 32 + fr, fq * 8);
#define PG8_SA(b, h) (((b) * 2 + (h)) * HTB)
#define PG8_SB(b, h) ((4 + (b) * 2 + (h)) * HTB)
#define PG8_STAGE(bufoff, gbase, voff) do { _Pragma("unroll") for (int _i = 0; _i < 2; ++_i) \
        __builtin_amdgcn_global_load_lds((const unsigned*)((const char*)(gbase) + (voff)[_i]), (LAS unsigned*)(lds + (bufoff) + ldsw + _i * 8192), 16, 0, 0); } while (0)
#define PG8_LDA(dst, b, h) do { _Pragma("unroll") for (int m = 0; m < 4; ++m) _Pragma("unroll") for (int k = 0; k < 2; ++k) dst[m][k] = *(const LAS bf16x8*)(lds + PG8_SA(b, h) + aoff + m * 2048 + k * 1024); } while (0)
#define PG8_LDB(dst, b, h) do { _Pragma("unroll") for (int n = 0; n < 2; ++n) _Pragma("unroll") for (int k = 0; k < 2; ++k) dst[n][k] = *(const LAS bf16x8*)(lds + PG8_SB(b, h) + boff + n * 2048 + k * 1024); } while (0)
#define PG8_MMA(ai, bj, At, Bt) do { __builtin_amdgcn_s_setprio(1); _Pragma("unroll") for (int m = 0; m < 4; ++m) _Pragma("unroll") for (int n = 0; n < 2; ++n) _Pragma("unroll") for (int k = 0; k < 2; ++k) \
        acc[ai][bj][m][n] = __builtin_amdgcn_mfma_f32_16x16x32_bf16(Bt[n][k], At[m][k], acc[ai][bj][m][n], 0, 0, 0); __builtin_amdgcn_s_setprio(0); } while (0)
#define PG8_WAIT_V(n) asm volatile("s_waitcnt vmcnt(" #n ")" ::: "memory")
#define PG8_WAIT_L(n) asm volatile("s_waitcnt lgkmcnt(" #n ")" ::: "memory")
#define PG8_BAR __builtin_amdgcn_s_barrier()
#define PG8_SCHED __builtin_amdgcn_sched_barrier(0)
    Unit cur, nxt; int ui = 0;
    if (!S.next(0, cur)) return;
    f32x4 acc[2][2][4][2];
#pragma unroll
    for (int a = 0; a < 2; ++a)
#pragma unroll
        for (int b = 0; b < 2; ++b)
#pragma unroll
            for (int m = 0; m < 4; ++m)
#pragma unroll
                for (int n = 0; n < 2; ++n) acc[a][b][m][n] = (f32x4){0.f, 0.f, 0.f, 0.f};
    bf16x8 At[4][2], B0[2][2], B1[2][2];
    const char* cA = (const char*)g.A + (size_t)cur.pm * tstep + (size_t)cur.koff * 2; const char* cB = (const char*)g.Bt + (size_t)cur.pn * tstep + (size_t)cur.koff * 2;
    E.prep(cur, lds + STAGE_BYTES, tid);
    PG8_STAGE(PG8_SB(0, 0), cB, voffB); PG8_STAGE(PG8_SB(0, 1), cB + hstep, voffB); PG8_STAGE(PG8_SA(0, 0), cA, voffA); PG8_STAGE(PG8_SA(0, 1), cA + hstep, voffA);
    if (wr == 1) PG8_BAR;
    PG8_WAIT_V(2); PG8_BAR;
    PG8_STAGE(PG8_SB(1, 0), cB + kstep, voffB); PG8_STAGE(PG8_SA(1, 0), cA + kstep, voffA); PG8_STAGE(PG8_SB(1, 1), cB + hstep + kstep, voffB);
    PG8_WAIT_V(6); PG8_BAR;
    for (;;) {
        const bool has_next = S.next(ui + 1, nxt);
        const char* nA = has_next ? (const char*)g.A + (size_t)nxt.pm * tstep + (size_t)nxt.koff * 2 : cA; const char* nB = has_next ? (const char*)g.Bt + (size_t)nxt.pn * tstep + (size_t)nxt.koff * 2 : cB;
        const int nt = cur.nt;
        for (int t = 0; t < nt; t += 2) {
            if constexpr (Epi::CHAIN) { if (t == 8 || t == 12) { E.mid(acc, cur, t == 8 ? 0 : 1, wr, wc, fr, fq); PG8_SCHED; } }
            const bool last = (t == nt - 2);
            const char* a1 = cA + (size_t)(t + 1) * kstep;
            const char* a2 = last ? nA : cA + (size_t)(t + 2) * kstep; const char* b2 = last ? nB : cB + (size_t)(t + 2) * kstep;
            const char* a3 = a2 + kstep; const char* b3 = b2 + kstep;
            PG8_LDB(B0, 0, 0); PG8_LDB(B1, 0, 1); PG8_SCHED; PG8_LDA(At, 0, 0); PG8_STAGE(PG8_SA(1, 1), a1 + hstep, voffA);
            PG8_WAIT_V(8); PG8_WAIT_L(0); PG8_BAR; PG8_MMA(0, 0, At, B0); PG8_MMA(0, 1, At, B1); PG8_BAR; PG8_SCHED;
            PG8_LDA(At, 0, 1); PG8_STAGE(PG8_SB(0, 0), b2, voffB); PG8_STAGE(PG8_SB(0, 1), b2 + hstep, voffB); PG8_STAGE(PG8_SA(0, 0), a2, voffA);
            PG8_WAIT_V(8); PG8_WAIT_L(0); PG8_BAR; PG8_MMA(1, 0, At, B0); PG8_MMA(1, 1, At, B1); PG8_BAR; PG8_SCHED;
            PG8_LDB(B0, 1, 0); PG8_LDB(B1, 1, 1); PG8_SCHED; PG8_LDA(At, 1, 0); PG8_STAGE(PG8_SA(0, 1), a2 + hstep, voffA);
            PG8_WAIT_V(8); PG8_WAIT_L(0); PG8_BAR; PG8_MMA(0, 0, At, B0); PG8_MMA(0, 1, At, B1); PG8_BAR; PG8_SCHED;
            PG8_LDA(At, 1, 1); PG8_STAGE(PG8_SB(1, 0), b3, voffB); PG8_STAGE(PG8_SB(1, 1), b3 + hstep, voffB); PG8_STAGE(PG8_SA(1, 0), a3, voffA);
            PG8_WAIT_V(8); PG8_WAIT_L(0); PG8_BAR; PG8_MMA(1, 0, At, B0); PG8_MMA(1, 1, At, B1); PG8_BAR; PG8_SCHED;
        }
        if (wr == 0) PG8_BAR;
        E(acc, cur, wr, wc, fr, fq, lds + STAGE_BYTES + (ui & 1) * 2048);
        if (!has_next) break;
        if (!(Epi::CHAIN && nxt.seg != 0))
#pragma unroll
        for (int a = 0; a < 2; ++a)
#pragma unroll
            for (int b = 0; b < 2; ++b)
#pragma unroll
                for (int m = 0; m < 4; ++m)
#pragma unroll
                    for (int n = 0; n < 2; ++n) acc[a][b][m][n] = (f32x4){0.f, 0.f, 0.f, 0.f};
        cur = nxt; cA = nA; cB = nB; ++ui;
        E.prep(cur, lds + STAGE_BYTES + (ui & 1) * 2048, tid);
        if (wr == 1) PG8_BAR;
    }
    PG8_WAIT_V(0);
    PG8_BAR;
#undef PG8_SA
#undef PG8_SB
#undef PG8_STAGE
#undef PG8_LDA
#undef PG8_LDB
#undef PG8_MMA
#undef PG8_WAIT_V
#undef PG8_WAIT_L
#undef PG8_BAR
#undef PG8_SCHED
}
}

template <int MODE> struct EpiSplit {
    static constexpr bool PERM = true, CHAIN = false;
    unsigned char* R; const float* ssq; const float* bgate; const float* qg; const float* kg; const float* rot;
    __device__ __forceinline__ void prep(const pg8::Unit& u, LAS unsigned char* sp, int tid) const {
        if (tid < 256) ((LAS float*)sp)[tid] = row_scale(ssq, u.pm * 256 + tid);
        else if (MODE == 0 && u.pn >= 13) ((LAS float*)sp)[tid] = bgate[(u.pn - 13) * 256 + (tid - 256)];
    }
    __device__ __forceinline__ void operator()(const f32x4 (&acc)[2][2][4][2], const pg8::Unit& u, int wr, int wc, int fr, int fq, LAS unsigned char* sp) const {
        const LAS float* rsl = (const LAS float*)sp + wr * 64 + fr; const LAS float* bsl = (const LAS float*)sp + 256;
        const int pn = u.pn; bf16_t* dst; int pitch, colt, act = 0;
        if (MODE == 0) {
            if (pn < 6) { dst = (bf16_t*)(R + (size_t)(pn >> 1) * (32 * MiB)); pitch = 512; colt = (pn & 1) * 256; act = (pn < 4) ? 3 : 0; }
            else if (pn < 13) { dst = (bf16_t*)(R + R_RQ + (size_t)(pn - 6) * (16 * MiB)); pitch = 256; colt = 0; act = (pn == 9) ? 1 : ((pn < 8) ? 4 : 0); }
            else { dst = (bf16_t*)(R + R_GATES); pitch = 3072; colt = (pn - 13) * 256; act = 2; }
        } else {
            if (pn < 11) { dst = (bf16_t*)(R + R_G); colt = pn * 256; } else { dst = (bf16_t*)(R + R_U); colt = (pn - 11) * 256; }
            pitch = DFF;
        }
        const int row0 = u.pm * 256 + wr * 64 + fr;
        if (MODE == 0 && act >= 3) {
            const int cwh = 64 * wc + 8 * fq;
            const float* gn = (pn < 2) ? qg : kg; const float osc = (pn < 2) ? C2 : ((pn == 7) ? 0.125f : 1.f);
#pragma unroll
            for (int ai = 0; ai < 2; ++ai)
#pragma unroll
                for (int m = 0; m < 4; ++m) {
                    const int row = row0 + ai * 128 + m * 16; const float s = rsl[ai * 128 + m * 16];
                    f32x4 v[2][2];
#pragma unroll
                    for (int bj = 0; bj < 2; ++bj)
#pragma unroll
                        for (int n = 0; n < 2; ++n) v[bj][n] = acc[ai][bj][m][n] * s;
                    if (act == 3) {
                        float q = 0.f;
#pragma unroll
                        for (int bj = 0; bj < 2; ++bj)
#pragma unroll
                            for (int n = 0; n < 2; ++n) q += (v[bj][n][0] * v[bj][n][0] + v[bj][n][1] * v[bj][n][1]) + (v[bj][n][2] * v[bj][n][2] + v[bj][n][3] * v[bj][n][3]);
                        q += __shfl_xor(q, 16); q += __shfl_xor(q, 32);
                        const float ri = rsqrtf(q * (1.f / 64.f) + EPS) * osc;
#pragma unroll
                        for (int bj = 0; bj < 2; ++bj)
#pragma unroll
                            for (int n = 0; n < 2; ++n) { const f32x4 g = *(const f32x4*)(gn + 32 * bj + 8 * fq + 4 * n); v[bj][n] = v[bj][n] * g * ri; }
                    } else {
                        const int pos = row & (SEQ - 1);
#pragma unroll
                        for (int n = 0; n < 2; ++n) { const f32x4 cs = *(const f32x4*)(rot + pos * 32 + 8 * fq + 4 * n), sn = *(const f32x4*)(rot + 4096 * 32 + pos * 32 + 8 * fq + 4 * n);
                            const f32x4 x1 = v[0][n], x2 = v[1][n]; v[0][n] = (x1 * cs - x2 * sn) * osc; v[1][n] = (x2 * cs + x1 * sn) * osc; }
                    }
#pragma unroll
                    for (int bj = 0; bj < 2; ++bj) { u32x4 w; w.x = cvt_pk_bf16(v[bj][0][0], v[bj][0][1]); w.y = cvt_pk_bf16(v[bj][0][2], v[bj][0][3]); w.z = cvt_pk_bf16(v[bj][1][0], v[bj][1][1]); w.w = cvt_pk_bf16(v[bj][1][2], v[bj][1][3]);
                        *(u32x4*)(dst + (size_t)row * pitch + colt + cwh + 32 * bj) = w; }
                }
            return;
        }
        const int cw0 = wc * 32 + 8 * fq;
#pragma unroll
        for (int ai = 0; ai < 2; ++ai)
#pragma unroll
            for (int m = 0; m < 4; ++m) {
                const int row = row0 + ai * 128 + m * 16; const float s = rsl[ai * 128 + m * 16];
#pragma unroll
                for (int bj = 0; bj < 2; ++bj) {
                    f32x4 v0 = acc[ai][bj][m][0] * s, v1 = acc[ai][bj][m][1] * s;
                    const int col = colt + bj * 128 + cw0;
                    if (act == 2) { const f32x4 b0 = *(const LAS f32x4*)(bsl + bj * 128 + cw0), b1 = *(const LAS f32x4*)(bsl + bj * 128 + cw0 + 4);
                        v0 += b0; v1 += b1;
#pragma unroll
                        for (int j = 0; j < 4; ++j) { v0[j] = sigmoidf_(v0[j]); v1[j] = sigmoidf_(v1[j]); } }
                    else if (act == 1) {
#pragma unroll
                        for (int j = 0; j < 4; ++j) { v0[j] = v0[j] * sigmoidf_(v0[j]); v1[j] = v1[j] * sigmoidf_(v1[j]); } }
                    u32x4 w; w.x = cvt_pk_bf16(v0[0], v0[1]); w.y = cvt_pk_bf16(v0[2], v0[3]); w.z = cvt_pk_bf16(v1[0], v1[1]); w.w = cvt_pk_bf16(v1[2], v1[3]);
                    *(u32x4*)(dst + (size_t)row * pitch + col) = w;
                }
            }
    }
};
struct EpiAcc {
    static constexpr bool PERM = true, CHAIN = true;
    const bf16_t* gates; bf16_t* Y;
    __device__ __forceinline__ void mid(f32x4 (&acc)[2][2][4][2], const pg8::Unit& u, int seg, int wr, int wc, int fr, int fq) const {
        asm volatile("" : "+v"(fr), "+v"(fq));
        const int row0 = u.pm * 256 + wr * 64 + fr, col0 = u.pn * 256 + wc * 32 + 8 * fq;
#pragma unroll
        for (int ai = 0; ai < 2; ++ai)
#pragma unroll
            for (int m = 0; m < 4; ++m) {
                const bf16_t* gp = gates + (size_t)(row0 + ai * 128 + m * 16) * 3072 + seg * 1024 + col0;
#pragma unroll
                for (int bj = 0; bj < 2; ++bj) {
                    const u32x4 gw = *(const u32x4*)(gp + bj * 128), hw = *(const u32x4*)(gp + 1024 + bj * 128);
                    f32x4 v0 = acc[ai][bj][m][0], v1 = acc[ai][bj][m][1];
                    v0[0] *= bflo(gw.x) * __builtin_amdgcn_rcpf(fmaxf(bflo(hw.x), 1e-20f)); v0[1] *= bfhi(gw.x) * __builtin_amdgcn_rcpf(fmaxf(bfhi(hw.x), 1e-20f));
                    v0[2] *= bflo(gw.y) * __builtin_amdgcn_rcpf(fmaxf(bflo(hw.y), 1e-20f)); v0[3] *= bfhi(gw.y) * __builtin_amdgcn_rcpf(fmaxf(bfhi(hw.y), 1e-20f));
                    v1[0] *= bflo(gw.z) * __builtin_amdgcn_rcpf(fmaxf(bflo(hw.z), 1e-20f)); v1[1] *= bfhi(gw.z) * __builtin_amdgcn_rcpf(fmaxf(bfhi(hw.z), 1e-20f));
                    v1[2] *= bflo(gw.w) * __builtin_amdgcn_rcpf(fmaxf(bflo(hw.w), 1e-20f)); v1[3] *= bfhi(gw.w) * __builtin_amdgcn_rcpf(fmaxf(bfhi(hw.w), 1e-20f));
                    acc[ai][bj][m][0] = v0; acc[ai][bj][m][1] = v1;
                }
                if (m & 1) asm volatile("" ::: "memory");
            }
    }
    __device__ __forceinline__ void prep(const pg8::Unit&, LAS unsigned char*, int) const {}
    __device__ __forceinline__ void operator()(f32x4 (&acc)[2][2][4][2], const pg8::Unit& u, int wr, int wc, int fr, int fq, LAS unsigned char*) const {
        const int row0 = u.pm * 256 + wr * 64 + fr, col0 = u.pn * 256 + wc * 32 + 8 * fq;
#pragma unroll
        for (int ai = 0; ai < 2; ++ai)
#pragma unroll
            for (int m = 0; m < 4; ++m) {
                const int row = row0 + ai * 128 + m * 16;
#pragma unroll
                for (int bj = 0; bj < 2; ++bj) {
                    const int col = col0 + bj * 128;
                    const u32x4 gw = *(const u32x4*)(gates + (size_t)row * 3072 + 2048 + col);
                    const f32x4 v0 = acc[ai][bj][m][0], v1 = acc[ai][bj][m][1];
                    u32x4 w; w.x = cvt_pk_bf16(v0[0] * bflo(gw.x), v0[1] * bfhi(gw.x)); w.y = cvt_pk_bf16(v0[2] * bflo(gw.y), v0[3] * bfhi(gw.y));
                    w.z = cvt_pk_bf16(v1[0] * bflo(gw.z), v1[1] * bfhi(gw.z)); w.w = cvt_pk_bf16(v1[2] * bflo(gw.w), v1[3] * bfhi(gw.w));
                    *(u32x4*)(Y + (size_t)row * DM + col) = w;
                }
            }
    }
};
struct EpiRes {
    static constexpr bool PERM = false, CHAIN = false;
    const float* xin; float* xout; bf16_t* xb; float* ssq;
    __device__ __forceinline__ void prep(const pg8::Unit&, LAS unsigned char*, int) const {}
    __device__ __forceinline__ void operator()(const f32x4 (&acc)[2][2][4][2], const pg8::Unit& u, int wr, int wc, int fr, int fq, LAS unsigned char*) const {
        const int row0 = u.pm * 256 + wr * 64 + fr, col0 = u.pn * 256 + wc * 32 + 4 * fq;
#pragma unroll
        for (int ai = 0; ai < 2; ++ai)
#pragma unroll
            for (int m = 0; m < 4; ++m) {
                const int row = row0 + ai * 128 + m * 16; const size_t off = (size_t)row * DM + col0; float q = 0.f;
#pragma unroll
                for (int bj = 0; bj < 2; ++bj)
#pragma unroll
                    for (int n = 0; n < 2; ++n) { const size_t o = off + bj * 128 + n * 16; const f32x4 xv = *(const f32x4*)(xin + o) + acc[ai][bj][m][n]; *(f32x4*)(xout + o) = xv;
                        q += (xv[0] * xv[0] + xv[1] * xv[1]) + (xv[2] * xv[2] + xv[3] * xv[3]);
                        u32x2 w; w.x = cvt_pk_bf16(xv[0], xv[1]); w.y = cvt_pk_bf16(xv[2], xv[3]); *(u32x2*)(xb + o) = w; }
                q += __shfl_xor(q, 16); q += __shfl_xor(q, 32);
                if (fq == 0) ssq[(size_t)row * 16 + u.pn * 4 + wc] = q;
            }
    }
};

struct Args { const float* in[21]; float* out; unsigned char* ws; int ph_lo, ph_hi; };
typedef const __attribute__((address_space(4))) Args CArgs;
enum { I_X = 0, I_RELB, I_NMG, I_WIN, I_BGATE, I_QG, I_KG, I_LAM, I_SUBLN, I_RETG, I_SCW, I_SCB, I_WDA, I_WRET, I_WSC, I_WOUT, I_NFG, I_WFFI, I_FCW, I_FCB, I_WFFO };

__device__ __forceinline__ float wave_sum(float v) {
#pragma unroll
    for (int o = 1; o < 64; o <<= 1) v += __shfl_xor(v, o);
    return v;
}

__device__ __forceinline__ void transpose_item(const float* W, int N, const float* gain, bf16_t* WT, int dpitch, int dcol, LAS float* scr, int item, int lane, const bool headperm = false) {
    const int nblk = N / 32, kb = item / nblk, nb = item % nblk, k0 = 64 * kb, n0 = 32 * nb;
#pragma unroll
    for (int i = 0; i < 8; ++i) { const int kk = 8 * i + (lane >> 3), n4 = (lane & 7) * 4;
        f32x4 w = *(const f32x4*)(W + (size_t)(k0 + kk) * N + n0 + n4); if (gain) w *= gain[k0 + kk];
        LAS float* d = scr + kk * 33 + n4; d[0] = w.x; d[1] = w.y; d[2] = w.z; d[3] = w.w; }
    LDS_WAIT(); asm volatile("" ::: "memory");
    const int c = lane & 7;
#pragma unroll
    for (int j = 0; j < 4; ++j) { const int n = (lane >> 3) + 8 * j; const LAS float* s = scr + (8 * c) * 33 + n;
        u32x4 o; o.x = cvt_pk_bf16(s[0 * 33], s[1 * 33]); o.y = cvt_pk_bf16(s[2 * 33], s[3 * 33]); o.z = cvt_pk_bf16(s[4 * 33], s[5 * 33]); o.w = cvt_pk_bf16(s[6 * 33], s[7 * 33]);
        int nr = n0 + n;
        if (headperm && (nr < 1024 || (nr >= 1536 && nr < 2048))) { const int L = nr & 255; nr = (nr & ~255) + 128 * ((L >> 5) & 1) + 32 * (L >> 6) + (L & 31); }
        *(u32x4*)(WT + (size_t)nr * dpitch + dcol + k0 + 8 * c) = o; }
    LDS_WAIT(); asm volatile("" ::: "memory");
}
__device__ __forceinline__ int rel_bucket(int n) {
    if (n < 16) return n;
    const float v = logf((float)n / 16.f) / 2.0794415416798357f * 16.f;
    const int b = 16 + (int)v; return b < 31 ? b : 31;
}
__device__ __forceinline__ void xpass(const float* x, bf16_t* xb, float* rs, int gw, int NGW, int lane) {
    for (int m = gw; m < MT; m += NGW) {
        const f32x4* xr = (const f32x4*)(x + (size_t)m * DM) + lane;
        f32x4 v[4]; float s = 0.f;
#pragma unroll
        for (int j = 0; j < 4; ++j) { v[j] = xr[64 * j]; s += (v[j].x * v[j].x + v[j].y * v[j].y) + (v[j].z * v[j].z + v[j].w * v[j].w); }
        s = wave_sum(s);
        if (lane < 16) rs[(size_t)m * 16 + lane] = (lane == 0) ? s : 0.f;
        u32x2* o = (u32x2*)(xb + (size_t)m * DM) + lane;
#pragma unroll
        for (int j = 0; j < 4; ++j) { u32x2 w; w.x = cvt_pk_bf16(v[j].x, v[j].y); w.y = cvt_pk_bf16(v[j].z, v[j].w); o[64 * j] = w; }
    }
}
__device__ __forceinline__ void phase_W(CArgs& a, int l, LAS unsigned char* lds, const int tid, const int bx, const int G) {
    unsigned char* ws = a.ws;
    const int lane = tid & 63, wave = tid >> 6;
    const int gw = bx * NWAVES + wave, NGW = G * NWAVES;
    LAS float* scr = (LAS float*)(lds + wave * 16384);
    constexpr int I0 = 16 * 200, I1 = 8 * 32, I2 = 4 * 32, I3 = 4 * 32, I4 = 16 * 32, I5 = 16 * 176, I6 = 44 * 32;
    constexpr int NITEMS = I0 + I1 + I2 + I3 + I4 + I5 + I6;
    for (int it = gw; it < NITEMS; it += NGW) {
        int r = it;
        if (r < I0) { transpose_item(a.in[I_WIN] + (size_t)l * DM * INW, INW, a.in[I_NMG] + l * DM, (bf16_t*)(ws + WS_WIN), DM, 0, scr, r, lane, true); continue; } r -= I0;
        if (r < I1) { transpose_item(a.in[I_WDA] + (size_t)l * 512 * DM, DM, nullptr, (bf16_t*)(ws + WS_WBR), DM, 0, scr, r, lane); continue; } r -= I1;
        if (r < I2) { transpose_item(a.in[I_WRET] + (size_t)l * 256 * DM, DM, nullptr, (bf16_t*)(ws + WS_WBR), DM, 512, scr, r, lane); continue; } r -= I2;
        if (r < I3) { transpose_item(a.in[I_WSC] + (size_t)l * 256 * DM, DM, nullptr, (bf16_t*)(ws + WS_WBR), DM, 768, scr, r, lane); continue; } r -= I3;
        if (r < I4) { transpose_item(a.in[I_WOUT] + (size_t)l * DM * DM, DM, nullptr, (bf16_t*)(ws + WS_WOUT), DM, 0, scr, r, lane); continue; } r -= I4;
        if (r < I5) { transpose_item(a.in[I_WFFI] + (size_t)l * DM * 2 * DFF, 2 * DFF, a.in[I_NFG] + l * DM, (bf16_t*)(ws + WS_WFFI), DM, 0, scr, r, lane); continue; } r -= I5;
        transpose_item(a.in[I_WFFO] + (size_t)l * DFF * DM, DM, nullptr, (bf16_t*)(ws + WS_WFFO), DFF, 0, scr, r, lane);
    }
    {
        LAS float* xs = (LAS float*)(lds + wave * 16384);
        const float* xsrc = (l == 0 ? a.in[I_X] : a.out);
        float* part = (float*)(ws + WS_PART);
        if ((gw & 3) == 0)
        for (int it = gw >> 2; it < 512; it += (NGW + 3) >> 2) {
            const int cg = it & 15, kc = it >> 4, k0 = kc * 32;
            { const f32x4* xr = (const f32x4*)(xsrc + ((size_t)(lane >> 3) * SEQ + (lane & 7)) * DM + k0);
#pragma unroll
              for (int i = 0; i < 8; ++i) { const f32x4 v = xr[i]; *(LAS f32x4*)(xs + lane * 36 + 4 * i) = v; } }
            float w[32];
            { const float* Wl = a.in[I_WIN] + (size_t)l * DM * INW + (size_t)k0 * INW + 1536 + cg * 64 + lane; const float* gm = a.in[I_NMG] + l * DM + k0;
#pragma unroll
              for (int kk = 0; kk < 32; ++kk) w[kk] = Wl[(size_t)kk * INW] * gm[kk]; }
            LDS_WAIT(); asm volatile("" ::: "memory");
#pragma unroll 4
            for (int r = 0; r < 64; ++r) { float acc = 0.f;
#pragma unroll
                for (int k4 = 0; k4 < 8; ++k4) { const f32x4 xv = *(const LAS f32x4*)(xs + r * 36 + 4 * k4); acc += xv.x * w[4 * k4] + xv.y * w[4 * k4 + 1] + xv.z * w[4 * k4 + 2] + xv.w * w[4 * k4 + 3]; }
                part[((size_t)kc * 64 + r) * 1024 + cg * 64 + lane] = acc; }
            LDS_WAIT(); asm volatile("" ::: "memory");
        }
    }
    const int gt = bx * NTHR + tid, NGT = G * NTHR;
    if (l == 0) {
        float* ct = (float*)(ws + WS_ROT); float* st = ct + 4096 * 32;
        for (int e = gt; e < 4096 * 32; e += NGT) {
            const int pos = e >> 5, i = e & 31;
            const float inv = exp2f(-(float)i * 0.41524101186092029f);
            const float ang = (float)pos * inv;
            const float kq = rintf(ang * 0.15915494309189535f);
            float rr = fmaf(-kq, 6.28125f, ang); rr = fmaf(-kq, 0.0019353071795864769f, rr);
            const float rev = rr * 0.15915494309189535f;
            ct[e] = __builtin_amdgcn_cosf(rev); st[e] = __builtin_amdgcn_sinf(rev);
        }
        float* bt = (float*)(ws + WS_BT);
        if (gt < 512) { const int h = gt >> 7, d = gt & 127; const float* rb = a.in[I_RELB];
            bt[gt] = (rb[rel_bucket(d) * 4 + h] - rb[31 * 4 + h]) * LOG2E; }
    }
    if (gt == 0) {
        const float* lp = a.in[I_LAM] + l * 256; float s1 = 0.f, s2 = 0.f;
        for (int i = 0; i < 64; ++i) { s1 += lp[i] * lp[64 + i]; s2 += lp[128 + i] * lp[192 + i]; }
        ((float*)(ws + WS_LAM))[l] = expf(s1) - expf(s2) + (0.8f - 0.6f * expf(-0.3f * (float)l));
    }
    if (l == 0) xpass(a.in[I_X], (bf16_t*)(ws + WS_XB), (float*)(ws + WS_SSQ), gw, NGW, lane);
}

__device__ __forceinline__ void reduce_hx(unsigned char* ws, const int tid, const int bx, const int G) {
    const f32x4* part = (const f32x4*)(ws + WS_PART); f32x4* hx = (f32x4*)(ws + WS_HX);
    for (int e = bx * NTHR + tid; e < 64 * 1024 / 4; e += G * NTHR) { f32x4 s = (f32x4){0.f, 0.f, 0.f, 0.f};
#pragma unroll 16
        for (int kc = 0; kc < 32; ++kc) s += part[(size_t)kc * 16384 + e];
        hx[e] = s; }
}

#include <hip/hip_bf16.h>
#include <cmath>
namespace attn_body {
using bf16=__hip_bfloat16;
using bf16x8=__attribute__((ext_vector_type(8)))short;
using s16x4=__attribute__((ext_vector_type(4)))short;
using f32x16=__attribute__((ext_vector_type(16)))float;
using u32x4=__attribute__((ext_vector_type(4)))unsigned;
constexpr int SEQ=4096,D=64,QP=512,KP=512,VP=512,OP=1024;
constexpr int NW=8,QBLK=32,QB=QBLK*NW,KVBLK=64,NQB=SEQ/QB;
__device__ __forceinline__ int crow(int r,int hi){return (r&3)+8*(r>>2)+4*hi;}
#define SBAR() __builtin_amdgcn_sched_barrier(0)
__device__ __forceinline__ void cmask(f32x16&p0,f32x16&p1,int jb,int qrel,int hi){
  const float NEG=-INFINITY; int kb=64*jb+4*hi;
  #pragma unroll
  for(int r=0;r<16;++r){int kv=kb+(r&3)+8*(r>>2); if(kv>qrel)p0[r]=NEG; if(kv+32>qrel)p1[r]=NEG;}
}

typedef __attribute__((address_space(3))) const float* lds_fptr;
__device__ __forceinline__ void biasmask(f32x16&p0,f32x16&p1,int jb,int qrel,int hi,lds_fptr Tl){
  const float NEG=-INFINITY; const int d00=qrel-(64*jb+4*hi);
  #pragma unroll
  for(int g=0;g<4;++g){
    #pragma unroll
    for(int q=0;q<4;++q){const int r=4*g+q; const int d0=d00-(q+8*g),d1=d0-32;
      const int i0=d0<0?0:(d0>127?127:d0),i1=d1<0?0:(d1>127?127:d1);
      const float b0=Tl[i0],b1=Tl[i1];
      p0[r]=d0<0?NEG:p0[r]+b0; p1[r]=d1<0?NEG:p1[r]+b1;}
    __builtin_amdgcn_sched_barrier(0);
  }
}

__device__ __forceinline__ void fillneg(f32x16&p0,f32x16&p1){
  #pragma unroll
  for(int r=0;r<16;++r){p0[r]=-INFINITY;p1[r]=-INFINITY;}
}
constexpr int NSLOT=3, SLOTB=8192;
constexpr int LDS_K=0, LDS_V=NSLOT*SLOTB, LDS_WS=2*NSLOT*SLOTB, LDS_OST=LDS_WS+NW*64*4, LDS_BT=LDS_OST+NW*4096, LDS_BYTES=LDS_BT+512;
constexpr float C2=0.125f*1.4426950408889634f;
__device__ __forceinline__ void glds16(const void*gsrc,unsigned lds_dst){unsigned keep;
  asm volatile("s_mov_b32 %0, m0\n\ts_mov_b32 m0, %2\n\ts_nop 0\n\tglobal_load_lds_dwordx4 %1, off\n\ts_mov_b32 m0, %0":"=&s"(keep):"v"(gsrc),"s"(lds_dst):"memory");}
__device__ __forceinline__ float max3f(float a,float b,float c){float r;asm("v_max3_f32 %0, %1, %2, %3":"=v"(r):"v"(a),"v"(b),"v"(c));return r;}
__device__ __forceinline__ float max2f(float a,float b){float r;asm("v_max_f32_e32 %0, %1, %2":"=v"(r):"v"(a),"v"(b));return r;}
__device__ __forceinline__ float fadd_s(float a,float b){float r;asm("v_add_f32_e32 %0, %1, %2":"=v"(r):"v"(a),"v"(b));return r;}
__device__ __forceinline__ float fsub_s(float a,float b){float r;asm("v_sub_f32_e32 %0, %1, %2":"=v"(r):"v"(a),"v"(b));return r;}
typedef float f32x2_t __attribute__((ext_vector_type(2))); typedef __bf16 bf16x2_t __attribute__((ext_vector_type(2)));
__device__ __forceinline__ unsigned cvtpk_s(float lo,float hi){f32x2_t v={lo,hi};bf16x2_t b=__builtin_convertvector(v,bf16x2_t);return __builtin_bit_cast(unsigned,b);}
#define WAIT_BAR(N) asm volatile("s_waitcnt vmcnt(" #N ") lgkmcnt(0)\n\ts_barrier":::"memory")

__device__ __forceinline__ void qkt(f32x16&p0,f32x16&p1,const char*Kslot,const bf16x8*qr,const f32x16&negm,int r32,int hi){
  const char*kb=Kslot+hi*1024+r32*16;
  #pragma unroll
  for(int d0=0;d0<4;++d0){
    const bf16x8 b0=*reinterpret_cast<const bf16x8*>(kb+d0*2048);
    const bf16x8 b1=*reinterpret_cast<const bf16x8*>(kb+d0*2048+512);
    if(d0==0){p0=__builtin_amdgcn_mfma_f32_32x32x16_bf16(b0,qr[0],negm,0,0,0);p1=__builtin_amdgcn_mfma_f32_32x32x16_bf16(b1,qr[0],negm,0,0,0);}
    else{p0=__builtin_amdgcn_mfma_f32_32x32x16_bf16(b0,qr[d0],p0,0,0,0);p1=__builtin_amdgcn_mfma_f32_32x32x16_bf16(b1,qr[d0],p1,0,0,0);}}
}
typedef __attribute__((address_space(3))) const char* lds_cptr;
typedef short v4i16_t __attribute__((ext_vector_type(4)));
__device__ __forceinline__ void kload8(bf16x8*kf,lds_cptr kp){
  kf[0]=*(const __attribute__((address_space(3))) bf16x8*)(kp);      kf[1]=*(const __attribute__((address_space(3))) bf16x8*)(kp+512);
  kf[2]=*(const __attribute__((address_space(3))) bf16x8*)(kp+2048); kf[3]=*(const __attribute__((address_space(3))) bf16x8*)(kp+2560);
  kf[4]=*(const __attribute__((address_space(3))) bf16x8*)(kp+4096); kf[5]=*(const __attribute__((address_space(3))) bf16x8*)(kp+4608);
  kf[6]=*(const __attribute__((address_space(3))) bf16x8*)(kp+6144); kf[7]=*(const __attribute__((address_space(3))) bf16x8*)(kp+6656);
}
__device__ __forceinline__ void kload2(bf16x8*kf,lds_cptr kp,int j){ kf[2*j]=*(const __attribute__((address_space(3))) bf16x8*)(kp+j*2048); kf[2*j+1]=*(const __attribute__((address_space(3))) bf16x8*)(kp+j*2048+512); }
__device__ __forceinline__ s16x4 vtr(lds_cptr p){ return __builtin_bit_cast(s16x4,__builtin_amdgcn_ds_read_tr16_b64_v4i16((__attribute__((address_space(3))) v4i16_t*)p)); }
__device__ __forceinline__ float rowmax(const f32x16&p0,const f32x16&p1){
  float a=max3f(p0[0],p0[1],p1[0]),b=max3f(p0[2],p0[3],p1[1]);a=max3f(a,p1[2],p1[3]);
  #pragma unroll
  for(int r=4;r<16;r+=4){a=max3f(a,p0[r],p0[r+1]);b=max3f(b,p0[r+2],p0[r+3]);a=max3f(a,p1[r],p1[r+1]);b=max3f(b,p1[r+2],p1[r+3]);}
  const float m=max2f(a,b);
  auto rr=__builtin_amdgcn_permlane32_swap(__float_as_uint(m),__float_as_uint(m),false,false);
  return max2f(__uint_as_float(rr[0]),__uint_as_float(rr[1]));
}
__device__ __forceinline__ void pv(f32x16*o,int vb,bf16x8 pa0,bf16x8 pa1,bf16x8 pa2,bf16x8 pa3){
  #pragma unroll
  for(int d0=0;d0<2;++d0){s16x4 lo[4],hi[4];
    #pragma unroll
    for(int ks=0;ks<4;++ks){
      asm volatile("ds_read_b64_tr_b16 %0,%1 offset:%c2":"=&v"(lo[ks]):"v"(vb),"i"(d0*4096+ks*1024):"memory");
      asm volatile("ds_read_b64_tr_b16 %0,%1 offset:%c2":"=&v"(hi[ks]):"v"(vb),"i"(d0*4096+ks*1024+512):"memory");}
    asm volatile("s_waitcnt lgkmcnt(0)":::"memory");SBAR();
    #define PK(k) (bf16x8){lo[k][0],lo[k][1],lo[k][2],lo[k][3],hi[k][0],hi[k][1],hi[k][2],hi[k][3]}
    o[d0]=__builtin_amdgcn_mfma_f32_32x32x16_bf16(pa0,PK(0),o[d0],0,0,0);
    o[d0]=__builtin_amdgcn_mfma_f32_32x32x16_bf16(pa1,PK(1),o[d0],0,0,0);
    o[d0]=__builtin_amdgcn_mfma_f32_32x32x16_bf16(pa2,PK(2),o[d0],0,0,0);
    o[d0]=__builtin_amdgcn_mfma_f32_32x32x16_bf16(pa3,PK(3),o[d0],0,0,0);
    #undef PK
  }
}

#ifndef ATTN_STORE16
#define ATTN_STORE16(p,v) (*(u32x4*)(p)=(v))
#endif
template<int THRL> __device__ __forceinline__ void attn_unit(int qb,const bf16*Qb,const bf16*__restrict__ Kh,const bf16*__restrict__ Vh,bf16*Ob,const float*BTg,char*shm,const int tid){
  const int lane=tid&63,r32=lane&31,hi=lane>>5; const int wid=__builtin_amdgcn_readfirstlane(tid>>6);
  const int q0=qb*QB;
  const bf16*Qw=Qb+(long)(q0+wid*QBLK)*QP;
  int tl_=tid; asm volatile("":"+v"(tl_)); float btv_=0.f; if(tl_<128)btv_=BTg[tl_];
  const lds_fptr Tl=(lds_fptr)((lds_cptr)shm+LDS_BT);
  const unsigned lds0=(unsigned)(uintptr_t)shm;
  float*wsf=(float*)(shm+LDS_WS)+wid*64;
  const bf16*ksrc=Kh+(long)lane*KP+wid*8;
  const bf16*vsrc=Vh+(long)(16*(wid&3)+(lane>>2))*VP+(wid>>2)*32+(lane&3)*8;
  const unsigned kdst=lds0+LDS_K+wid*1024, vdst=lds0+LDS_V+wid*1024;
  #define DMA_K(t,slot) glds16(ksrc+(long)(t)*KVBLK*KP,(unsigned)__builtin_amdgcn_readfirstlane(kdst+(slot)))
  #define DMA_V(t,slot) glds16(vsrc+(long)(t)*KVBLK*VP,(unsigned)__builtin_amdgcn_readfirstlane(vdst+(slot)))
  const int vb0=(int)(lds0+LDS_V)+((lane>>4)&1)*32+(lane&3)*8+(4*hi+((lane&15)>>2))*64;
  const char*Kbase=shm+LDS_K; bf16x8 kf[8];
  const lds_cptr shm3=(lds_cptr)shm; const lds_cptr kp0=shm3+LDS_K+hi*1024+r32*16; const lds_cptr vp0=shm3+LDS_V+((lane>>4)&1)*32+(lane&3)*8+(4*hi+((lane&15)>>2))*64;
  const int NT=(q0+QB)/KVBLK;
  DMA_K(0,0);DMA_V(0,0);DMA_K(1,SLOTB);
  bf16x8 qr[4];
  #pragma unroll
  for(int d0=0;d0<4;++d0)qr[d0]=*reinterpret_cast<const bf16x8*>(&Qw[(long)r32*QP+d0*16+hi*8]);
  float zz_=0.f;asm volatile("":"+v"(zz_));
  float mhat=zz_,l_reg=zz_;f32x16 o[2],negm;
  _Pragma("unroll") for(int r=0;r<16;++r){o[0][r]=zz_;o[1][r]=zz_;negm[r]=zz_;} asm volatile("":"+v"(negm));
  const int qrel=wid*QBLK+r32;
  #define CMASK(P0,P1,t) do{int jb_=(t)-(NT-4); if(64*jb_+176>32*wid)biasmask(P0,P1,jb_,qrel,hi,Tl); }while(0)
  bool resc=false;
  #define START(P0,P1) do{ const float rm=rowmax(P0,P1); resc=false; \
    { const float dl=rm; mhat=fadd_s(mhat,dl); \
      _Pragma("unroll") for(int r=0;r<16;++r){P0[r]=fsub_s(P0[r],dl);P1[r]=fsub_s(P1[r],dl);} \
      _Pragma("unroll") for(int r=0;r<16;++r)negm[r]=-mhat; asm volatile("":"+v"(negm)); } \
    _Pragma("unroll") for(int r=0;r<16;++r)P0[r]=__builtin_amdgcn_exp2f(P0[r]); }while(0)
  #define RESC() do{ if(resc){ asm volatile("s_waitcnt lgkmcnt(0)":::"memory"); \
      _Pragma("unroll") for(int d_=0;d_<2;++d_) _Pragma("unroll") for(int r=0;r<16;++r)o[d_][r]*=wsf[crow(r,hi)]; } }while(0)
  f32x16 pA0,pA1,pB0,pB1;
  int sl_prev=0,sl_cur=0,sl_next=SLOTB;
  #define ROT() do{sl_prev=sl_cur;sl_cur=sl_next;sl_next=(sl_next==(NSLOT-1)*SLOTB)?0:sl_next+SLOTB;}while(0)
  { float*tw=(float*)(shm+LDS_BT); if(tl_<128)tw[tl_]=btv_; }
  DMA_K(2,2*SLOTB);
  WAIT_BAR(3);
  qkt(pA0,pA1,Kbase,qr,negm,r32,hi);asm volatile("s_nop 15\n\ts_nop 7":"+v"(pA0),"+v"(pA1));CMASK(pA0,pA1,0);
  START(pA0,pA1);
  _Pragma("unroll") for(int r=0;r<16;++r)pA1[r]=__builtin_amdgcn_exp2f(pA1[r]);
  WAIT_BAR(0);
  DMA_K(3,0);DMA_V(1,SLOTB);
  ROT();
  kload8(kf,kp0+sl_cur);
  WAIT_BAR(2);
  s16x4 vlo[8],vhi[8]; u32x4 pw0,pw1,pw2,pw3;
  #define PKW(P,B) cvtpk_s(P[B],P[B+1])
  #define PAF(k) __builtin_bit_cast(bf16x8,pw##k)
  #define VFR(i) (bf16x8){vlo[i][0],vlo[i][1],vlo[i][2],vlo[i][3],vhi[i][0],vhi[i][1],vhi[i][2],vhi[i][3]}
  #define PIN(x) asm volatile("":"+v"(x))
  #define MX3(a,b,c) __builtin_fmaxf(__builtin_fmaxf((a),(b)),(c))
  #define GAPA(MF,A0,A1,A2,A3,W0,W1,PW) do{ MF; sacc+=A0; sacc+=A1; sacc+=A2; sacc+=A3; PIN(sacc); W0; W1; PIN(PW); SBAR(); }while(0)
  #define EX(v) __builtin_amdgcn_exp2f(v)
  #define GAPB(MF,X,B) do{ MF; X[B]=EX(X[B]); X[B+1]=EX(X[B+1]); X[B+2]=EX(X[B+2]); X[B+3]=EX(X[B+3]); PIN(X); SBAR(); }while(0)
  #define VRD(i) do{ vlo[i]=vtr(vp_+(((i)>>2)*4096+((i)&3)*1024)); vhi[i]=vtr(vp_+(((i)>>2)*4096+((i)&3)*1024+512)); }while(0)
  #define KRD(G,j) do{ if(G){ kload2(kf,kp0+sl_next,j); SBAR(); } }while(0)
  #define STEP(C0,C1,P0,P1,t,GK,GV,GL) do{ SBAR(); \
    const lds_cptr vp_=vp0+sl_prev; \
    VRD(0); SBAR(); float sacc=(P0[0]+P0[1]); \
    GAPA(C0=__builtin_amdgcn_mfma_f32_32x32x16_bf16(kf[0],qr[0],negm,0,0,0), P0[2],P0[3],P0[4],P0[5],     pw0[0]=PKW(P0,0), pw0[1]=PKW(P0,2), pw0); \
    VRD(4); SBAR(); GAPA(C1=__builtin_amdgcn_mfma_f32_32x32x16_bf16(kf[1],qr[0],negm,0,0,0), P0[6],P0[7],P0[8],P0[9],     pw0[2]=PKW(P0,4), pw0[3]=PKW(P0,6), pw0); \
    VRD(1); SBAR(); GAPA(C0=__builtin_amdgcn_mfma_f32_32x32x16_bf16(kf[2],qr[1],C0,0,0,0),   P0[10],P0[11],P0[12],P0[13], pw1[0]=PKW(P0,8), pw1[1]=PKW(P0,10), pw1); \
    VRD(5); SBAR(); GAPA(C1=__builtin_amdgcn_mfma_f32_32x32x16_bf16(kf[3],qr[1],C1,0,0,0),   P0[14],P0[15],P1[0],P1[1],   pw1[2]=PKW(P0,12),pw1[3]=PKW(P0,14), pw1); \
    VRD(2); SBAR(); GAPA(C0=__builtin_amdgcn_mfma_f32_32x32x16_bf16(kf[4],qr[2],C0,0,0,0),   P1[2],P1[3],P1[4],P1[5],     pw2[0]=PKW(P1,0), pw2[1]=PKW(P1,2), pw2); \
    VRD(6); SBAR(); GAPA(C1=__builtin_amdgcn_mfma_f32_32x32x16_bf16(kf[5],qr[2],C1,0,0,0),   P1[6],P1[7],P1[8],P1[9],     pw2[2]=PKW(P1,4), pw2[3]=PKW(P1,6), pw2); \
    VRD(3); SBAR(); GAPA(C0=__builtin_amdgcn_mfma_f32_32x32x16_bf16(kf[6],qr[3],C0,0,0,0),   P1[10],P1[11],P1[12],P1[13], pw3[0]=PKW(P1,8), pw3[1]=PKW(P1,10), pw3); \
    VRD(7); SBAR(); GAPA(C1=__builtin_amdgcn_mfma_f32_32x32x16_bf16(kf[7],qr[3],C1,0,0,0),   P1[14],P1[15],0.f,0.f,       pw3[2]=PKW(P1,12),pw3[3]=PKW(P1,14), pw3); \
    l_reg+=sacc; \
    if(GK){DMA_K((t)+3,sl_cur);} if(GV){DMA_V((t)+1,sl_next);} \
    CMASK(C0,C1,t); \
    { float a=MX3(C0[0],C0[1],C1[0]),b=MX3(C0[2],C0[3],C1[1]); a=MX3(a,C1[2],C1[3]); \
      _Pragma("unroll") for(int r=4;r<16;r+=4){a=MX3(a,C0[r],C0[r+1]);b=MX3(b,C0[r+2],C0[r+3]);a=MX3(a,C1[r],C1[r+1]);b=MX3(b,C1[r+2],C1[r+3]);} \
      float rm=__builtin_fmaxf(a,b); { auto rr=__builtin_amdgcn_permlane32_swap(__float_as_uint(rm),__float_as_uint(rm),false,false); rm=__builtin_fmaxf(__uint_as_float(rr[0]),__uint_as_float(rr[1])); } \
      resc=false; \
      if(__builtin_expect(__any(rm>(float)THRL),0)){ const float dl=__builtin_fmaxf(rm,0.f); mhat+=dl; \
        _Pragma("unroll") for(int r=0;r<16;++r){C0[r]-=dl;C1[r]-=dl;} \
        _Pragma("unroll") for(int r=0;r<16;++r)negm[r]=-mhat; asm volatile("":"+v"(negm)); \
        const float f=__builtin_amdgcn_exp2f(-dl); l_reg*=f; if(hi==0)wsf[r32]=f; resc=true; } } \
    SBAR(); \
    GAPB(o[0]=__builtin_amdgcn_mfma_f32_32x32x16_bf16(PAF(0),VFR(0),o[0],0,0,0), C0,0); \
    GAPB(o[1]=__builtin_amdgcn_mfma_f32_32x32x16_bf16(PAF(0),VFR(4),o[1],0,0,0), C0,4); \
    KRD(GL,0); GAPB(o[0]=__builtin_amdgcn_mfma_f32_32x32x16_bf16(PAF(1),VFR(1),o[0],0,0,0), C0,8); \
    KRD(GL,1); GAPB(o[1]=__builtin_amdgcn_mfma_f32_32x32x16_bf16(PAF(1),VFR(5),o[1],0,0,0), C0,12); \
    KRD(GL,2); GAPB(o[0]=__builtin_amdgcn_mfma_f32_32x32x16_bf16(PAF(2),VFR(2),o[0],0,0,0), C1,0); \
    KRD(GL,3); GAPB(o[1]=__builtin_amdgcn_mfma_f32_32x32x16_bf16(PAF(2),VFR(6),o[1],0,0,0), C1,4); \
    GAPB(o[0]=__builtin_amdgcn_mfma_f32_32x32x16_bf16(PAF(3),VFR(3),o[0],0,0,0), C1,8); \
    GAPB(o[1]=__builtin_amdgcn_mfma_f32_32x32x16_bf16(PAF(3),VFR(7),o[1],0,0,0), C1,12); \
    }while(0)
  int t=1;
  #undef CMASK
  #define CMASK(P0,P1,t) do{}while(0)
  for(;t+7<NT;t+=2){
    STEP(pB0,pB1,pA0,pA1,t,true,true,true);     WAIT_BAR(2); RESC(); ROT();
    STEP(pA0,pA1,pB0,pB1,t+1,true,true,true);   WAIT_BAR(2); RESC(); ROT();
  }
  #undef CMASK
  #define CMASK(P0,P1,t) do{int jb_=(t)-(NT-4); if(64*jb_+176>32*wid)biasmask(P0,P1,jb_,qrel,hi,Tl); }while(0)
  #define ENDW(tt) do{ if((tt)+3<NT){WAIT_BAR(2);} else if((tt)+2<NT){WAIT_BAR(1);} else {WAIT_BAR(0);} }while(0)
  for(;t+1<NT;t+=2){
    STEP(pB0,pB1,pA0,pA1,t,(t+3<NT),(t+1<NT),(t+1<NT));       ENDW(t);   RESC(); ROT();
    STEP(pA0,pA1,pB0,pB1,t+1,(t+4<NT),(t+2<NT),(t+2<NT));     ENDW(t+1); RESC(); ROT();
  }
  STEP(pB0,pB1,pA0,pA1,NT-1,false,false,false); RESC();
  { float sacc=pB0[0]+pB0[1]; _Pragma("unroll") for(int r=2;r<16;++r)sacc+=pB0[r]; _Pragma("unroll") for(int r=0;r<16;++r)sacc+=pB1[r]; l_reg+=sacc;
    pw0=(u32x4){PKW(pB0,0),PKW(pB0,2),PKW(pB0,4),PKW(pB0,6)};pw1=(u32x4){PKW(pB0,8),PKW(pB0,10),PKW(pB0,12),PKW(pB0,14)};pw2=(u32x4){PKW(pB1,0),PKW(pB1,2),PKW(pB1,4),PKW(pB1,6)};pw3=(u32x4){PKW(pB1,8),PKW(pB1,10),PKW(pB1,12),PKW(pB1,14)};
    SBAR(); pv(o,vb0+sl_cur,PAF(0),PAF(1),PAF(2),PAF(3)); }
  #undef PKW
  #undef PAF
  #undef VFR
  #undef PIN
  #undef MX3
  #undef GAPA
  #undef GAPB
  #undef EX
  #undef VRD
  #undef KRD
  #undef STEP
  #undef ENDW
  {auto rr=__builtin_amdgcn_permlane32_swap(__float_as_uint(l_reg),__float_as_uint(l_reg),false,false);l_reg=__uint_as_float(rr[0])+__uint_as_float(rr[1]);}
  if(hi==0)wsf[32+r32]=l_reg;asm volatile("s_waitcnt lgkmcnt(0)":::"memory");
  float rli[16];
  #pragma unroll
  for(int r=0;r<16;++r)rli[r]=__builtin_amdgcn_rcpf(wsf[32+crow(r,hi)]);
  bf16*Ow=Ob+(long)(q0+wid*QBLK)*OP;
  { bf16*stg=(bf16*)(shm+LDS_OST)+wid*2048;
    #pragma unroll
    for(int r=0;r<16;++r){const int orow=crow(r,hi);
      #pragma unroll
      for(int d0=0;d0<2;++d0)stg[orow*64+d0*32+r32]=__float2bfloat16(o[d0][r]*rli[r]);}
    asm volatile("s_waitcnt lgkmcnt(0)":::"memory");
    #pragma unroll
    for(int i=0;i<4;++i){const int row=i*8+(lane>>3),ch=lane&7; const u32x4 v=*(const u32x4*)(stg+row*64+ch*8); ATTN_STORE16(Ow+(long)row*OP+ch*8,v);} }
  asm volatile("s_waitcnt lgkmcnt(0)\n\ts_barrier":::"memory");
  #undef DMA_K
  #undef DMA_V
  #undef CMASK
  #undef START
  #undef RESC
  #undef ROT
}
constexpr int ATTN_LDS_BYTES=LDS_BYTES;
#undef SBAR
#undef WAIT_BAR
}

namespace fa3 {
constexpr int KP = 72;
typedef float f32x2_t __attribute__((ext_vector_type(2))); typedef __bf16 bf16x2_t __attribute__((ext_vector_type(2)));
__device__ __forceinline__ unsigned cvtpk(float lo, float hi) { f32x2_t v = {lo, hi}; bf16x2_t b = __builtin_convertvector(v, bf16x2_t); return __builtin_bit_cast(unsigned, b); }
__device__ __forceinline__ void unit(unsigned char* ws, LAS unsigned char* lds, int b, int h, int mp, int qb, const int tid_in) {
    int tid = tid_in; asm volatile("" : "+v"(tid));
    const int lane = tid & 63, w = __builtin_amdgcn_readfirstlane(tid >> 6), fr = lane & 15, fq = lane >> 4;
    const bf16_t* Q = (const bf16_t*)(ws + WS_R + R_Q) + (size_t)b * SEQ * 512 + (h * 2 + mp) * 64;
    const bf16_t* K = (const bf16_t*)(ws + WS_R + R_K) + (size_t)b * SEQ * 512 + (h * 2 + mp) * 64;
    const bf16_t* V = (const bf16_t*)(ws + WS_R + R_V) + (size_t)b * SEQ * 512 + h * 128;
    bf16_t* O = (bf16_t*)(ws + WS_XB) + (size_t)b * SEQ * 1024 + h * 256 + mp * 128;
    const float* BTg = (const float*)(ws + WS_BT) + h * 128;
    constexpr int KVB = (64 + 128) * KP;
    LAS bf16_t* KV0 = (LAS bf16_t*)lds; LAS float* TB = (LAS float*)(KV0 + 2 * KVB);
    const int q0 = qb * 256, qw0 = q0 + 32 * w, NT = 4 * qb + 4;
    __syncthreads();
    { const int d_ = tid - 256; TB[tid] = d_ < 0 ? -INFINITY : (d_ < 128 ? BTg[d_] : 0.f); }
    bf16x8 qf[2][2];
#pragma unroll
    for (int g = 0; g < 2; ++g) { const bf16_t* qp = Q + (size_t)(qw0 + 16 * g + fr) * 512 + 8 * fq; qf[g][0] = *(const bf16x8*)qp; qf[g][1] = *(const bf16x8*)(qp + 32); }
    float m[2] = {0.f, 0.f}; f32x4 lacc[2] = {(f32x4){0.f, 0.f, 0.f, 0.f}, (f32x4){0.f, 0.f, 0.f, 0.f}}; f32x4 o[2][8];
    const bf16x8 onesf = {0x3F80, 0x3F80, 0x3F80, 0x3F80, 0x3F80, 0x3F80, 0x3F80, 0x3F80};
#pragma unroll
    for (int g = 0; g < 2; ++g)
#pragma unroll
        for (int et = 0; et < 8; ++et) o[g][et] = (f32x4){0.f, 0.f, 0.f, 0.f};
    const int sr = tid >> 3, sc = tid & 7;
    const bf16_t* kg = K + (size_t)sr * 512 + sc * 8;
    const int vp = tid >> 4, vc = tid & 15;
    const bf16_t* vg = V + (size_t)(2 * vp) * 512 + vc * 8;
    u32x4 kA = *(const u32x4*)kg, vA0 = *(const u32x4*)vg, vA1 = *(const u32x4*)(vg + 512);
    u32x4 kB = *(const u32x4*)(kg + (size_t)64 * 512), vB0 = *(const u32x4*)(vg + (size_t)64 * 512), vB1 = *(const u32x4*)(vg + (size_t)64 * 512 + 512);
#define FA3_STAGE(BUF) do { LAS bf16_t* ks_ = KV0 + (BUF) * KVB; LAS bf16_t* vt_ = ks_ + 64 * KP; *(LAS u32x4*)(ks_ + sr * KP + sc * 8) = kA; \
        const unsigned va_[4] = {vA0.x, vA0.y, vA0.z, vA0.w}, vb_[4] = {vA1.x, vA1.y, vA1.z, vA1.w}; const int k2_ = 2 * vp; \
        const int col_ = ((k2_ & 32) + 8 * ((k2_ >> 2) & 3) + 4 * ((k2_ >> 4) & 1) + (k2_ & 3) + 8 * (vc >> 1)) & 63;     \
        _Pragma("unroll") for (int w_ = 0; w_ < 4; ++w_) { *(LAS unsigned*)(vt_ + (vc * 8 + 2 * w_) * KP + col_) = (va_[w_] & 0xffffu) | (vb_[w_] << 16); \
            *(LAS unsigned*)(vt_ + (vc * 8 + 2 * w_ + 1) * KP + col_) = (va_[w_] >> 16) | (vb_[w_] & 0xffff0000u); } } while (0)
    FA3_STAGE(0);
    kA = kB; vA0 = vB0; vA1 = vB1;
    { const size_t off = (size_t)2 * 64 * 512; kB = *(const u32x4*)(kg + off); vB0 = *(const u32x4*)(vg + off); vB1 = *(const u32x4*)(vg + off + 512); }
    __syncthreads();
    for (int kt = 0; kt < NT; ++kt) {
        LAS bf16_t* KS = KV0 + (kt & 1) * KVB; LAS bf16_t* VT = KS + 64 * KP;
        const int k0 = kt * 64;
        if (k0 <= qw0 + 31) {
        f32x4 s[2][4];
#pragma unroll
        for (int jt = 0; jt < 4; ++jt) { const bf16x8 kf0 = *(const LAS bf16x8*)(KS + (16 * jt + fr) * KP + 8 * fq), kf1 = *(const LAS bf16x8*)(KS + (16 * jt + fr) * KP + 32 + 8 * fq);
#pragma unroll
            for (int g = 0; g < 2; ++g) { const float nm = -m[g]; s[g][jt] = __builtin_amdgcn_mfma_f32_16x16x32_bf16(kf0, qf[g][0], (f32x4){nm, nm, nm, nm}, 0, 0, 0); s[g][jt] = __builtin_amdgcn_mfma_f32_16x16x32_bf16(kf1, qf[g][1], s[g][jt], 0, 0, 0); } }
        const bool nearb = (qw0 - (k0 + 63) < 113);
        bf16x8 pf[2][2];
#pragma unroll
        for (int g = 0; g < 2; ++g) {
            if (nearb) {
                const LAS float* tb = TB + (256 + qw0 + 16 * g + fr - (k0 + 4 * fq));
#pragma unroll
                for (int jt = 0; jt < 4; ++jt)
#pragma unroll
                    for (int jj = 0; jj < 4; ++jj) { const float bv = tb[-(16 * jt + jj)]; float x = s[g][jt][jj];
                        asm("v_add_f32_e32 %0, %1, %2" : "=v"(x) : "v"(x), "v"(bv));
                        s[g][jt][jj] = x; }
            }
            float mx = fmaxf(fmaxf(s[g][0][0], s[g][0][1]), fmaxf(s[g][0][2], s[g][0][3]));
#pragma unroll
            for (int jt = 1; jt < 4; ++jt) mx = fmaxf(mx, fmaxf(fmaxf(s[g][jt][0], s[g][jt][1]), fmaxf(s[g][jt][2], s[g][jt][3])));
            if (__any(mx > 8.f)) {
                mx = fmaxf(mx, __shfl_xor(mx, 16)); mx = fmaxf(mx, __shfl_xor(mx, 32));
                const float dl = fmaxf(mx, 0.f), alpha = __builtin_amdgcn_exp2f(-dl);
                m[g] += dl; lacc[g] *= alpha;
#pragma unroll
                for (int jt = 0; jt < 4; ++jt) s[g][jt] -= dl;
#pragma unroll
                for (int et = 0; et < 8; ++et) o[g][et] *= alpha;
            }
#pragma unroll
            for (int jt = 0; jt < 4; ++jt) {
#pragma unroll
                for (int jj = 0; jj < 4; ++jj) s[g][jt][jj] = __builtin_amdgcn_exp2f(s[g][jt][jj]); }
#pragma unroll
            for (int sb = 0; sb < 2; ++sb) { u32x4 pw; pw.x = cvtpk(s[g][2 * sb][0], s[g][2 * sb][1]); pw.y = cvtpk(s[g][2 * sb][2], s[g][2 * sb][3]); pw.z = cvtpk(s[g][2 * sb + 1][0], s[g][2 * sb + 1][1]); pw.w = cvtpk(s[g][2 * sb + 1][2], s[g][2 * sb + 1][3]);
                pf[g][sb] = __builtin_bit_cast(bf16x8, pw); }
        }
#pragma unroll
        for (int g = 0; g < 2; ++g) {
            lacc[g] = __builtin_amdgcn_mfma_f32_16x16x32_bf16(onesf, pf[g][0], lacc[g], 0, 0, 0); lacc[g] = __builtin_amdgcn_mfma_f32_16x16x32_bf16(onesf, pf[g][1], lacc[g], 0, 0, 0); }
#pragma unroll
        for (int et = 0; et < 8; ++et) { const LAS bf16_t* vrow = VT + (16 * et + fr) * KP;
            const bf16x8 vf0 = *(const LAS bf16x8*)(vrow + ((8 * fq + 8 * et) & 63)), vf1 = *(const LAS bf16x8*)(vrow + ((32 + 8 * fq + 8 * et) & 63));
#pragma unroll
            for (int g = 0; g < 2; ++g) { o[g][et] = __builtin_amdgcn_mfma_f32_16x16x32_bf16(vf0, pf[g][0], o[g][et], 0, 0, 0); o[g][et] = __builtin_amdgcn_mfma_f32_16x16x32_bf16(vf1, pf[g][1], o[g][et], 0, 0, 0); } }
        }
        if (kt + 1 < NT) { FA3_STAGE((kt + 1) & 1); kA = kB; vA0 = vB0; vA1 = vB1;
            if (kt + 3 < NT) { const size_t off = (size_t)(kt + 3) * 64 * 512; kB = *(const u32x4*)(kg + off); vB0 = *(const u32x4*)(vg + off); vB1 = *(const u32x4*)(vg + off + 512); } }
        __syncthreads();
    }
#pragma unroll
    for (int g = 0; g < 2; ++g) {
        const float il = __builtin_amdgcn_rcpf(lacc[g][0]);
#pragma unroll
        for (int et = 0; et < 8; ++et) { u32x2 ow; ow.x = cvtpk(o[g][et][0] * il, o[g][et][1] * il); ow.y = cvtpk(o[g][et][2] * il, o[g][et][3] * il);
            *(u32x2*)(O + (size_t)(qw0 + 16 * g + fr) * 1024 + 16 * et + 4 * fq) = ow; }
    }
}
#undef FA3_STAGE
}

constexpr int RP64 = 72, RP128 = 136;
__device__ __forceinline__ void retkv_unit(unsigned char* ws, LAS unsigned char* lds, int u, const int tid) {
    const int b = u >> 7, h = (u >> 5) & 3, n = u & 31;
    const int lane = tid & 63, w = __builtin_amdgcn_readfirstlane(tid >> 6), fr = lane & 15, fq = lane >> 4;
    const bf16_t* RK = (const bf16_t*)(ws + WS_R + R_RK); const bf16_t* RV = (const bf16_t*)(ws + WS_R + R_RV);
    const float lg2 = log2f(1.f - exp2f(-5.f - (float)h));
    const size_t row0 = (size_t)b * SEQ + n * 128;
    LAS bf16_t* VT = (LAS bf16_t*)lds; LAS bf16_t* KT = VT + 64 * RP128;
    __syncthreads();
    { const int r = tid >> 2, c0 = (tid & 3) * 16;
      const u32x4* vs = (const u32x4*)(RV + (row0 + r) * 256 + h * 64 + c0); const u32x4 a0 = vs[0], a1 = vs[1];
      const u32x4* ksrc = (const u32x4*)(RK + (row0 + r) * 256 + h * 64 + c0); const u32x4 k0 = ksrc[0], k1 = ksrc[1];
      const unsigned vw[8] = {a0.x, a0.y, a0.z, a0.w, a1.x, a1.y, a1.z, a1.w}; const unsigned kw[8] = {k0.x, k0.y, k0.z, k0.w, k1.x, k1.y, k1.z, k1.w};
      const float dec = exp2f(lg2 * (float)(127 - r));
#pragma unroll
      for (int i = 0; i < 8; ++i) { VT[(c0 + 2 * i) * RP128 + r] = (bf16_t)(vw[i] & 0xffffu); VT[(c0 + 2 * i + 1) * RP128 + r] = (bf16_t)(vw[i] >> 16);
          const unsigned kp = cvt_pk_bf16(bflo(kw[i]) * dec, bfhi(kw[i]) * dec);
          KT[(c0 + 2 * i) * RP128 + r] = (bf16_t)(kp & 0xffffu); KT[(c0 + 2 * i + 1) * RP128 + r] = (bf16_t)(kp >> 16); } }
    __syncthreads();
    const int et = w >> 1;
#pragma unroll
    for (int t2 = 0; t2 < 2; ++t2) { const int dt = (w & 1) * 2 + t2; f32x4 acc = (f32x4){0.f, 0.f, 0.f, 0.f};
#pragma unroll
        for (int sb = 0; sb < 4; ++sb) { const bf16x8 kf = *(const LAS bf16x8*)(KT + (16 * dt + fr) * RP128 + 32 * sb + 8 * fq); const bf16x8 vf = *(const LAS bf16x8*)(VT + (16 * et + fr) * RP128 + 32 * sb + 8 * fq);
            acc = __builtin_amdgcn_mfma_f32_16x16x32_bf16(kf, vf, acc, 0, 0, 0); }
        u32x2 o; o.x = cvt_pk_bf16(acc[0], acc[1]); o.y = cvt_pk_bf16(acc[2], acc[3]);
        *(u32x2*)((bf16_t*)(ws + WS_KV) + (size_t)u * 4096 + (16 * et + fr) * 64 + 16 * dt + 4 * fq) = o; }
}
typedef float f32x2_c __attribute__((ext_vector_type(2))); typedef __bf16 bf16x2_c __attribute__((ext_vector_type(2)));
__device__ __forceinline__ unsigned cvtpk_c(float lo, float hi) { f32x2_c v = {lo, hi}; bf16x2_c b = __builtin_convertvector(v, bf16x2_c); return __builtin_bit_cast(unsigned, b); }
__device__ __forceinline__ void retkv_mfma_unit(unsigned char* ws, LAS unsigned char* lds, int u, const int tid) {
    const int b = u >> 7, h = (u >> 5) & 3, n = u & 31;
    const int lane = tid & 63, w = __builtin_amdgcn_readfirstlane(tid >> 6), fr = lane & 15, fq = lane >> 4;
    const bf16_t* RK = (const bf16_t*)(ws + WS_R + R_RK); const bf16_t* RV = (const bf16_t*)(ws + WS_R + R_RV);
    const float lg2 = log2f(1.f - exp2f(-5.f - (float)h));
    const size_t row0 = (size_t)b * SEQ + n * 128;
    LAS bf16_t* VT = (LAS bf16_t*)lds; LAS bf16_t* KT = VT + 64 * RP128;
    __syncthreads();
    { const int r = tid >> 2, c0 = (tid & 3) * 16;
      const u32x4* vs = (const u32x4*)(RV + (row0 + r) * 256 + h * 64 + c0); const u32x4 a0 = vs[0], a1 = vs[1];
      const u32x4* ksrc = (const u32x4*)(RK + (row0 + r) * 256 + h * 64 + c0); const u32x4 k0 = ksrc[0], k1 = ksrc[1];
      const unsigned vw[8] = {a0.x, a0.y, a0.z, a0.w, a1.x, a1.y, a1.z, a1.w}; const unsigned kw[8] = {k0.x, k0.y, k0.z, k0.w, k1.x, k1.y, k1.z, k1.w};
      const float dec = exp2f(lg2 * (float)(127 - r));
#pragma unroll
      for (int i = 0; i < 8; ++i) { VT[(c0 + 2 * i) * RP128 + r] = (bf16_t)(vw[i] & 0xffffu); VT[(c0 + 2 * i + 1) * RP128 + r] = (bf16_t)(vw[i] >> 16);
          const unsigned kp = cvt_pk_bf16(bflo(kw[i]) * dec, bfhi(kw[i]) * dec);
          KT[(c0 + 2 * i) * RP128 + r] = (bf16_t)(kp & 0xffffu); KT[(c0 + 2 * i + 1) * RP128 + r] = (bf16_t)(kp >> 16); } }
    __syncthreads();
    const int et = w >> 1;
#pragma unroll
    for (int t2 = 0; t2 < 2; ++t2) { const int dt = (w & 1) * 2 + t2; f32x4 acc = (f32x4){0.f, 0.f, 0.f, 0.f};
#pragma unroll
        for (int sb = 0; sb < 4; ++sb) { const bf16x8 kf = *(const LAS bf16x8*)(KT + (16 * dt + fr) * RP128 + 32 * sb + 8 * fq); const bf16x8 vf = *(const LAS bf16x8*)(VT + (16 * et + fr) * RP128 + 32 * sb + 8 * fq);
            acc = __builtin_amdgcn_mfma_f32_16x16x32_bf16(kf, vf, acc, 0, 0, 0); }
        u32x2 o; o.x = cvtpk_c(acc[0], acc[1]); o.y = cvtpk_c(acc[2], acc[3]);
        *(u32x2*)((bf16_t*)(ws + WS_KV) + (size_t)u * 4096 + (16 * et + fr) * 64 + 16 * dt + 4 * fq) = o; }
}
__device__ __forceinline__ void retkv_naive_unit(unsigned char* ws, unsigned char* lds, int u, const int tid) {
    const int b = u >> 7, h = (u >> 5) & 3, n = u & 31;
    const bf16_t* RK = (const bf16_t*)(ws + WS_R + R_RK); const bf16_t* RV = (const bf16_t*)(ws + WS_R + R_RV);
    const float lg2 = log2f(1.f - exp2f(-5.f - (float)h));
    const size_t row0 = (size_t)b * SEQ + n * 128;
    bf16_t* KS = (bf16_t*)lds; bf16_t* VS = KS + 128 * 72;
    __syncthreads();
    { const int r = tid >> 2, c0 = (tid & 3) * 16;
      const u32x4* ksrc = (const u32x4*)(RK + (row0 + r) * 256 + h * 64 + c0); const u32x4 k0 = ksrc[0], k1 = ksrc[1];
      const u32x4* vsrc = (const u32x4*)(RV + (row0 + r) * 256 + h * 64 + c0); const u32x4 v0 = vsrc[0], v1 = vsrc[1];
      *(u32x4*)(KS + r * 72 + c0) = k0; *(u32x4*)(KS + r * 72 + c0 + 8) = k1; *(u32x4*)(VS + r * 72 + c0) = v0; *(u32x4*)(VS + r * 72 + c0 + 8) = v1; }
    __syncthreads();
    const int d = tid >> 3, eg = tid & 7;
    float av[8];
#pragma unroll
    for (int i = 0; i < 8; ++i) av[i] = 0.f;
#pragma unroll 8
    for (int c = 0; c < 128; ++c) {
        const float kd = bf2f(KS[c * 72 + d]) * exp2f(lg2 * (float)(127 - c));
        const u32x4 v = *(const u32x4*)(VS + c * 72 + eg * 8);
        av[0] += kd * bflo(v.x); av[1] += kd * bfhi(v.x); av[2] += kd * bflo(v.y); av[3] += kd * bfhi(v.y);
        av[4] += kd * bflo(v.z); av[5] += kd * bfhi(v.z); av[6] += kd * bflo(v.w); av[7] += kd * bfhi(v.w);
    }
#pragma unroll
    for (int i = 0; i < 8; ++i) ((bf16_t*)(ws + WS_KV))[(size_t)u * 4096 + (eg * 8 + i) * 64 + d] = (bf16_t)(cvt_pk_bf16(av[i], 0.f) & 0xffffu);
}
__device__ __forceinline__ void phase_B1(CArgs& a, int l, unsigned char* lds, const int tid, const int bx, const int G) {
    {
        for (int vc = bx; vc < 256; vc += G) {
            const int vcu = (G == 256) ? ((vc & 7) * 32 + (vc >> 3)) : vc;
            const int combo = vcu >> 2, s = vcu & 3;
            const int b = combo >> 3, h = (combo >> 1) & 3, mp = combo & 1;
            for (int i = 0; i < 4; ++i) { const int qb = (i == 0) ? s : (i == 1) ? 7 - s : (i == 2) ? 8 + s : 15 - s; fa3::unit(a.ws, (LAS unsigned char*)lds, b, h, mp, qb, tid); }
        }
    }
    { int tid2 = tid; asm volatile("" : "+v"(tid2)); for (int u = bx; u < 1024; u += G) retkv_mfma_unit(a.ws, (LAS unsigned char*)lds, u, tid2); }
}

__device__ __forceinline__ void retout_unit(CArgs& a, int l, unsigned char* lds, int u, const int tid) {
    unsigned char* ws = a.ws;
    const int b = u >> 7, h = (u >> 5) & 3, n = u & 31;
    const int lane = tid & 63, w = __builtin_amdgcn_readfirstlane(tid >> 6), fr = lane & 15, fq = lane >> 4;
    const bf16_t* RQ = (const bf16_t*)(ws + WS_R + R_RQ); const bf16_t* RK = (const bf16_t*)(ws + WS_R + R_RK); const bf16_t* RV = (const bf16_t*)(ws + WS_R + R_RV);
    const bf16_t* RG = (const bf16_t*)(ws + WS_R + R_RG); const bf16_t* KV = (const bf16_t*)(ws + WS_KV);
    bf16_t* OC = (bf16_t*)(ws + WS_R + R_OCAT);
    const float lg2 = log2f(1.f - exp2f(-5.f - (float)h));
    const size_t row0 = (size_t)b * SEQ + n * 128;
    LAS bf16_t* KS = (LAS bf16_t*)lds; LAS bf16_t* VT = KS + 128 * RP64; LAS bf16_t* RT = VT + 64 * RP128; LAS bf16_t* PS = RT + 64 * RP64;
    __syncthreads();
    { const int r = tid >> 2, c0 = (tid & 3) * 16;
      const u32x4* ksrc = (const u32x4*)(RK + (row0 + r) * 256 + h * 64 + c0); const u32x4 k0 = ksrc[0], k1 = ksrc[1];
      *(LAS u32x4*)(KS + r * RP64 + c0) = k0; *(LAS u32x4*)(KS + r * RP64 + c0 + 8) = k1;
      const u32x4* vs = (const u32x4*)(RV + (row0 + r) * 256 + h * 64 + c0); const u32x4 a0 = vs[0], a1 = vs[1];
      const unsigned vw[8] = {a0.x, a0.y, a0.z, a0.w, a1.x, a1.y, a1.z, a1.w};
#pragma unroll
      for (int i = 0; i < 8; ++i) { VT[(c0 + 2 * i) * RP128 + r] = (bf16_t)(vw[i] & 0xffffu); VT[(c0 + 2 * i + 1) * RP128 + r] = (bf16_t)(vw[i] >> 16); } }
    { float r[8];
#pragma unroll
      for (int i = 0; i < 8; ++i) r[i] = 0.f;
#pragma unroll 8
      for (int m = 0; m < n; ++m) { const float wgt = exp2f(lg2 * 128.f * (float)(n - 1 - m)); const u32x4 v = *(const u32x4*)(KV + (size_t)(u - n + m) * 4096 + tid * 8);
          r[0] += wgt * bflo(v.x); r[1] += wgt * bfhi(v.x); r[2] += wgt * bflo(v.y); r[3] += wgt * bfhi(v.y); r[4] += wgt * bflo(v.z); r[5] += wgt * bfhi(v.z); r[6] += wgt * bflo(v.w); r[7] += wgt * bfhi(v.w); }
      u32x4 o; o.x = cvt_pk_bf16(r[0], r[1]); o.y = cvt_pk_bf16(r[2], r[3]); o.z = cvt_pk_bf16(r[4], r[5]); o.w = cvt_pk_bf16(r[6], r[7]);
      *(LAS u32x4*)(RT + (tid >> 3) * RP64 + (tid & 7) * 8) = o; }
    const int c = 16 * w + fr; const size_t row = row0 + c;
    const bf16x8 qf0 = *(const bf16x8*)(RQ + row * 256 + h * 64 + 8 * fq), qf1 = *(const bf16x8*)(RQ + row * 256 + h * 64 + 32 + 8 * fq);
    __syncthreads();
    for (int jt = 0; jt <= w; ++jt) {
        f32x4 s = (f32x4){0.f, 0.f, 0.f, 0.f};
        const bf16x8 kf0 = *(const LAS bf16x8*)(KS + (16 * jt + fr) * RP64 + 8 * fq), kf1 = *(const LAS bf16x8*)(KS + (16 * jt + fr) * RP64 + 32 + 8 * fq);
        s = __builtin_amdgcn_mfma_f32_16x16x32_bf16(kf0, qf0, s, 0, 0, 0); s = __builtin_amdgcn_mfma_f32_16x16x32_bf16(kf1, qf1, s, 0, 0, 0);
        const int dj0 = c - (16 * jt + 4 * fq); float p[4];
#pragma unroll
        for (int jj = 0; jj < 4; ++jj) { const int dj = dj0 - jj; p[jj] = dj >= 0 ? s[jj] * exp2f(lg2 * (float)dj) : 0.f; }
        u32x2 pw; pw.x = cvt_pk_bf16(p[0], p[1]); pw.y = cvt_pk_bf16(p[2], p[3]);
        *(LAS u32x2*)(PS + c * RP128 + 16 * jt + 4 * fq) = pw;
    }
    if (!(w & 1)) { unsigned zq = 0u; asm volatile("" : "+v"(zq)); u32x2 z; z.x = zq; z.y = zq; *(LAS u32x2*)(PS + c * RP128 + 16 * (w + 1) + 4 * fq) = z; }
    LDS_WAIT(); asm volatile("" ::: "memory");
    f32x4 o[4], x[4];
#pragma unroll
    for (int et = 0; et < 4; ++et) { o[et] = (f32x4){0.f, 0.f, 0.f, 0.f}; x[et] = (f32x4){0.f, 0.f, 0.f, 0.f}; }
    for (int sb = 0; sb <= (w >> 1); ++sb) {
        const bf16x8 pf = *(const LAS bf16x8*)(PS + c * RP128 + 32 * sb + 8 * fq);
#pragma unroll
        for (int et = 0; et < 4; ++et) { const bf16x8 vf = *(const LAS bf16x8*)(VT + (16 * et + fr) * RP128 + 32 * sb + 8 * fq); o[et] = __builtin_amdgcn_mfma_f32_16x16x32_bf16(vf, pf, o[et], 0, 0, 0); }
    }
#pragma unroll
    for (int et = 0; et < 4; ++et) { const bf16x8 r0 = *(const LAS bf16x8*)(RT + (16 * et + fr) * RP64 + 8 * fq), r1 = *(const LAS bf16x8*)(RT + (16 * et + fr) * RP64 + 32 + 8 * fq);
        x[et] = __builtin_amdgcn_mfma_f32_16x16x32_bf16(r0, qf0, x[et], 0, 0, 0); x[et] = __builtin_amdgcn_mfma_f32_16x16x32_bf16(r1, qf1, x[et], 0, 0, 0); }
    const float qd = exp2f(lg2 * (float)(c + 1));
    float ss = 0.f;
#pragma unroll
    for (int et = 0; et < 4; ++et) { o[et] += x[et] * qd; ss += (o[et][0] * o[et][0] + o[et][1] * o[et][1]) + (o[et][2] * o[et][2] + o[et][3] * o[et][3]); }
    ss += __shfl_xor(ss, 16); ss += __shfl_xor(ss, 32);
    const float ri = rsqrtf(ss * (1.f / 64.f) + EPS);
    const bool head_rows = (n == 0 && c < 8);
#pragma unroll
    for (int et = 0; et < 4; ++et) { const int e0 = 16 * et + 4 * fq;
        const u32x2 gw = *(const u32x2*)(RG + row * 256 + h * 64 + e0); const f32x4 gg = *(const f32x4*)(a.in[I_RETG] + l * 64 + e0);
        u32x2 ow; ow.x = cvt_pk_bf16(o[et][0] * ri * gg[0] * bflo(gw.x), o[et][1] * ri * gg[1] * bfhi(gw.x)); ow.y = cvt_pk_bf16(o[et][2] * ri * gg[2] * bflo(gw.y), o[et][3] * ri * gg[3] * bfhi(gw.y));
        if (!head_rows) *(u32x2*)(OC + row * 1024 + 512 + h * 64 + e0) = ow; }
    if (n == 0) {
        __syncthreads();
        float* pr = (float*)lds;
        { const float* hx = (const float*)(ws + WS_HX); const float* ssqv = (const float*)(ws + WS_SSQ);
#pragma unroll
          for (int i = 0; i < 4; ++i) { const int e = tid + i * 512, t = e >> 8, cc = e & 255;
              pr[e] = hx[(size_t)(b * 8 + t) * 1024 + (cc >> 6) * 256 + h * 64 + (cc & 63)] * row_scale(ssqv, b * SEQ + t); } }
        __syncthreads();
        { const int t = tid >> 6, i = tid & 31, isk = (tid >> 5) & 1; float* p = pr + t * 256 + isk * 64;
          const float* ctb = (const float*)(ws + WS_ROT); const float cs = ctb[t * 32 + i], sn = ctb[4096 * 32 + t * 32 + i];
          const float x1 = p[i], x2 = p[i + 32], sc = isk ? 0.125f : 1.f;
          p[i] = (x1 * cs - x2 * sn) * sc; p[i + 32] = (x2 * cs + x1 * sn) * sc; }
        __syncthreads();
        { const int t = tid >> 6, e = tid & 63; float o = 0.f;
          for (int j = 0; j <= t; ++j) { float d = 0.f;
              for (int dd = 0; dd < 64; ++dd) d += pr[t * 256 + dd] * pr[j * 256 + 64 + dd];
              o += d * exp2f(lg2 * (float)(t - j)) * pr[j * 256 + 128 + e]; }
          const float ss2 = wave_sum(o * o); const float ri2 = rsqrtf(ss2 * (1.f / 64.f) + EPS);
          const float gv = pr[t * 256 + 192 + e];
          const float val = o * ri2 * a.in[I_RETG][l * 64 + e] * gv * sigmoidf_(gv);
          OC[((size_t)b * SEQ + t) * 1024 + 512 + h * 64 + e] = (bf16_t)(cvt_pk_bf16(val, 0.f) & 0xffffu); }
    }
}
__device__ __forceinline__ void phase_B2(CArgs& a, int l, unsigned char* lds, const int tid, const int bx, const int G) {
    unsigned char* ws = a.ws; unsigned char* R = ws + WS_R;
    const int lane = tid & 63, wave = tid >> 6;
    const int gw = bx * NWAVES + wave, NGW = G * NWAVES;
    for (int up = bx; up < 1024; up += G) { const int u = (up & ~31) | ((up + 8 * (up >> 8)) & 31);
        retout_unit(a, l, lds, u, tid); }
    const float lam = ((const float*)(ws + WS_LAM))[l];
    const float post = 1.f - (0.8f - 0.6f * expf(-0.3f * (float)l));
    const bf16_t* OR = (const bf16_t*)(ws + WS_XB); bf16_t* OC = (bf16_t*)(R + R_OCAT);
    const bf16_t* SB = (const bf16_t*)(R + R_SCB); const bf16_t* SC = (const bf16_t*)(R + R_SCC); const bf16_t* SX = (const bf16_t*)(R + R_SCX);
#pragma unroll 4
    for (int row = gw; row < MT; row += NGW) {
        {
            const int h = lane >> 4, e0 = (lane & 15) * 8;
            const u32x4 w0 = *(const u32x4*)(OR + (size_t)row * 1024 + h * 256 + e0), w1 = *(const u32x4*)(OR + (size_t)row * 1024 + h * 256 + 128 + e0);
            float v[8] = {bflo(w0.x) - lam * bflo(w1.x), bfhi(w0.x) - lam * bfhi(w1.x), bflo(w0.y) - lam * bflo(w1.y), bfhi(w0.y) - lam * bfhi(w1.y),
                          bflo(w0.z) - lam * bflo(w1.z), bfhi(w0.z) - lam * bfhi(w1.z), bflo(w0.w) - lam * bflo(w1.w), bfhi(w0.w) - lam * bfhi(w1.w)};
            float s = 0.f;
#pragma unroll
            for (int i = 0; i < 8; ++i) s += v[i] * v[i];
            s += __shfl_xor(s, 1); s += __shfl_xor(s, 2); s += __shfl_xor(s, 4); s += __shfl_xor(s, 8);
            const float r = rsqrtf(s * (1.f / 128.f) + EPS) * post; const float* g = a.in[I_SUBLN] + l * 128 + e0;
            u32x4 o; o.x = cvt_pk_bf16(v[0] * r * g[0], v[1] * r * g[1]); o.y = cvt_pk_bf16(v[2] * r * g[2], v[3] * r * g[3]);
            o.z = cvt_pk_bf16(v[4] * r * g[4], v[5] * r * g[5]); o.w = cvt_pk_bf16(v[6] * r * g[6], v[7] * r * g[7]);
            *(u32x4*)(OC + (size_t)row * 1024 + h * 128 + e0) = o;
        }
        if (lane < 32) {
            const int ch = lane * 8, pos = row & (SEQ - 1);
            const float* cw = a.in[I_SCW] + l * 3 * 256 + ch; const float* cb = a.in[I_SCB] + l * 256 + ch;
            float y[8];
#pragma unroll
            for (int i = 0; i < 8; ++i) y[i] = cb[i];
#pragma unroll
            for (int k = 0; k < 3; ++k) { const int dt = 2 - k; if (pos >= dt) {
                const u32x4 cv = *(const u32x4*)(SC + (size_t)(row - dt) * 256 + ch), xv = *(const u32x4*)(SX + (size_t)(row - dt) * 256 + ch); const float* w = cw + k * 256;
                y[0] += w[0] * bflo(cv.x) * bflo(xv.x); y[1] += w[1] * bfhi(cv.x) * bfhi(xv.x); y[2] += w[2] * bflo(cv.y) * bflo(xv.y); y[3] += w[3] * bfhi(cv.y) * bfhi(xv.y);
                y[4] += w[4] * bflo(cv.z) * bflo(xv.z); y[5] += w[5] * bfhi(cv.z) * bfhi(xv.z); y[6] += w[6] * bflo(cv.w) * bflo(xv.w); y[7] += w[7] * bfhi(cv.w) * bfhi(xv.w); } }
            const u32x4 bv = *(const u32x4*)(SB + (size_t)row * 256 + ch);
            u32x4 o; o.x = cvt_pk_bf16(y[0] * bflo(bv.x), y[1] * bfhi(bv.x)); o.y = cvt_pk_bf16(y[2] * bflo(bv.y), y[3] * bfhi(bv.y));
            o.z = cvt_pk_bf16(y[4] * bflo(bv.z), y[5] * bfhi(bv.z)); o.w = cvt_pk_bf16(y[6] * bflo(bv.w), y[7] * bfhi(bv.w));
            *(u32x4*)(OC + (size_t)row * 1024 + 768 + ch) = o;
        }
    }
}

__device__ __forceinline__ void phase_F(CArgs& a, int l, const int tid, const int bx, const int G) {
    unsigned char* R = a.ws + WS_R;
    const bf16_t* Gb = (const bf16_t*)(R + R_G); bf16_t* U = (bf16_t*)(R + R_U);
    const int gt = bx * NTHR + tid, NGT = G * NTHR;
    constexpr int CPR = DFF / 8, SEGR = 32, NSEG = MT / SEGR;
    for (int it = gt; it < NSEG * CPR; it += NGT) {
        const int seg = it / CPR, ch = (it - seg * CPR) * 8, row0 = seg * SEGR;
        const float* cw = a.in[I_FCW] + (size_t)l * 3 * DFF + ch; const float* cbp = a.in[I_FCB] + (size_t)l * DFF + ch;
        const f32x4 w0a = *(const f32x4*)(cw), w0b = *(const f32x4*)(cw + 4), w1a = *(const f32x4*)(cw + DFF), w1b = *(const f32x4*)(cw + DFF + 4), w2a = *(const f32x4*)(cw + 2 * DFF), w2b = *(const f32x4*)(cw + 2 * DFF + 4);
        const f32x4 cba = *(const f32x4*)(cbp), cbb = *(const f32x4*)(cbp + 4);
        u32x4 gm2 = (u32x4){0u, 0u, 0u, 0u}, gm1 = (u32x4){0u, 0u, 0u, 0u};
        if ((row0 & (SEQ - 1)) != 0) { gm2 = *(const u32x4*)(Gb + (size_t)(row0 - 2) * DFF + ch); gm1 = *(const u32x4*)(Gb + (size_t)(row0 - 1) * DFF + ch); }
#pragma unroll 4
        for (int r = 0; r < SEGR; ++r) {
            const size_t off = (size_t)(row0 + r) * DFF + ch;
            const u32x4 g0 = *(const u32x4*)(Gb + off); const u32x4 uv = *(const u32x4*)(U + off);
            f32x4 ya = cba, yb = cbb;
            ya += w0a * (f32x4){bflo(gm2.x), bfhi(gm2.x), bflo(gm2.y), bfhi(gm2.y)}; yb += w0b * (f32x4){bflo(gm2.z), bfhi(gm2.z), bflo(gm2.w), bfhi(gm2.w)};
            ya += w1a * (f32x4){bflo(gm1.x), bfhi(gm1.x), bflo(gm1.y), bfhi(gm1.y)}; yb += w1b * (f32x4){bflo(gm1.z), bfhi(gm1.z), bflo(gm1.w), bfhi(gm1.w)};
            ya += w2a * (f32x4){bflo(g0.x), bfhi(g0.x), bflo(g0.y), bfhi(g0.y)};     yb += w2b * (f32x4){bflo(g0.z), bfhi(g0.z), bflo(g0.w), bfhi(g0.w)};
#pragma unroll
            for (int i = 0; i < 4; ++i) { ya[i] = ya[i] * sigmoidf_(ya[i]); yb[i] = yb[i] * sigmoidf_(yb[i]); }
            u32x4 o; o.x = cvt_pk_bf16(ya[0] * bflo(uv.x), ya[1] * bfhi(uv.x)); o.y = cvt_pk_bf16(ya[2] * bflo(uv.y), ya[3] * bfhi(uv.y));
            o.z = cvt_pk_bf16(yb[0] * bflo(uv.z), yb[1] * bfhi(uv.z)); o.w = cvt_pk_bf16(yb[2] * bflo(uv.w), yb[3] * bfhi(uv.w));
            *(u32x4*)(U + off) = o;
            gm2 = gm1; gm1 = g0;
        }
    }
}
constexpr int PH_PER_LAYER = 9, NPH = PH_PER_LAYER * DEPTH;
__global__ void __launch_bounds__(NTHR, 2) mk_fwd(Args a_by_value) {
    extern __shared__ __attribute__((aligned(16))) unsigned char lds[];
    LAS unsigned char* ldsl = (LAS unsigned char*)lds;
    const int ph_lo = a_by_value.ph_lo, ph_hi = a_by_value.ph_hi;
    const int wave_s = __builtin_amdgcn_readfirstlane((int)threadIdx.x >> 6);
#define PHASE_ENTER(k) int tid, wv_ = wave_s, bx = blockIdx.x, G = gridDim.x, l = lq; CArgs* ka = (CArgs*)__builtin_amdgcn_kernarg_segment_ptr(); \
        asm volatile("; phase " #k "\n\tv_mbcnt_lo_u32_b32 %0, -1, 0\n\tv_mbcnt_hi_u32_b32 %0, -1, %0\n\tv_lshl_or_b32 %0, %1, 6, %0" : "=&v"(tid), "+s"(wv_), "+s"(l), "+s"(bx), "+s"(G), "+s"(ka)); CArgs& a = *ka; unsigned char* ws = a.ws; unsigned char* R = ws + WS_R; (void)R; (void)G; (void)bx; (void)tid
    for (int ph = ph_lo; ph < ph_hi; ++ph) {
        int lq = ph / PH_PER_LAYER, p = ph - lq * PH_PER_LAYER;
        asm volatile("" : "+s"(lq), "+s"(p));
        if (p == 0) { PHASE_ENTER(0); phase_W(a, l, ldsl, tid, bx, G); }
        else if (p == 1) {
            PHASE_ENTER(1);
            reduce_hx(ws, tid, bx, G);
            pg8::Gemm g{(const bf16_t*)(ws + WS_XB), (const bf16_t*)(ws + WS_WIN), DM}; pg8::Order S; S.init(MT, INW, G, bx, 1, DM / 64);
            EpiSplit<0> E{R, (const float*)(ws + WS_SSQ), a.in[I_BGATE] + l * 3072, a.in[I_QG] + l * 64, a.in[I_KG] + l * 64, (const float*)(ws + WS_ROT)};
            pg8::gemm_phase(ldsl, g, S, E, tid);
        }
        else if (p == 2) { PHASE_ENTER(2); phase_B1(a, l, lds, tid, bx, G); }
        else if (p == 3) { PHASE_ENTER(3); phase_B2(a, l, lds, tid, bx, G); }
        else if (p == 4) {
            PHASE_ENTER(4);
            pg8::Gemm g{(const bf16_t*)(R + R_OCAT), (const bf16_t*)(ws + WS_WBR), DM}; pg8::Order S; S.init(MT, DM, G, bx, 1, DM / 64);
            EpiAcc E{(const bf16_t*)(R + R_GATES), (bf16_t*)(R + R_Y)};
            pg8::gemm_phase(ldsl, g, S, E, tid);
        }
        else if (p == 5) {
            PHASE_ENTER(5);
            pg8::Gemm g{(const bf16_t*)(R + R_Y), (const bf16_t*)(ws + WS_WOUT), DM}; pg8::Order S; S.init(MT, DM, G, bx, 1, DM / 64);
            EpiRes E{l == 0 ? a.in[I_X] : a.out, a.out, (bf16_t*)(ws + WS_XB), (float*)(ws + WS_SSQ)};
            pg8::gemm_phase(ldsl, g, S, E, tid);
        }
        else if (p == 6) {
            PHASE_ENTER(6);
            pg8::Gemm g{(const bf16_t*)(ws + WS_XB), (const bf16_t*)(ws + WS_WFFI), DM}; pg8::Order S; S.init(MT, 2 * DFF, G, bx, 1, DM / 64);
            EpiSplit<1> E{R, (const float*)(ws + WS_SSQ), nullptr, nullptr, nullptr, nullptr};
            pg8::gemm_phase(ldsl, g, S, E, tid);
        }
        else if (p == 7) { PHASE_ENTER(7); phase_F(a, l, tid, bx, G); }
        else {
            PHASE_ENTER(8);
            pg8::Gemm g{(const bf16_t*)(R + R_U), (const bf16_t*)(ws + WS_WFFO), DFF}; pg8::Order S; S.init(MT, DM, G, bx, 1, DFF / 64);
            EpiRes E{a.out, a.out, (bf16_t*)(ws + WS_XB), (float*)(ws + WS_SSQ)};
            pg8::gemm_phase(ldsl, g, S, E, tid);
        }
        if (ph + 1 < ph_hi) cg::this_grid().sync();
    }
}

extern "C" void kernel_launch(void* const* d_in, const int* in_sizes, int n_in, void* d_out, int out_size, void* d_ws, size_t ws_size, hipStream_t stream) {
    static int grid = 0;
    if (grid == 0) {
        if (n_in != 21 || out_size != MT * DM || ws_size < WS_END) { fprintf(stderr, "kernel_launch: unexpected problem (n_in %d out %d ws %zu)\n", n_in, out_size, ws_size); grid = -1; return; }
        int dev = 0, cus = 0;
        hipGetDevice(&dev); hipDeviceGetAttribute(&cus, hipDeviceAttributeMultiprocessorCount, dev);
        if (hipFuncSetAttribute((const void*)mk_fwd, hipFuncAttributeMaxDynamicSharedMemorySize, LDS_BYTES) != hipSuccess) { fprintf(stderr, "kernel_launch: hipFuncSetAttribute failed\n"); grid = -1; return; }
        int per_cu = 0;
        if (hipOccupancyMaxActiveBlocksPerMultiprocessor(&per_cu, (const void*)mk_fwd, NTHR, LDS_BYTES) != hipSuccess || per_cu < 1) fprintf(stderr, "kernel_launch: occupancy query says %d\n", per_cu);
        (void)hipGetLastError();
        grid = cus > 0 ? cus : 256;
    }
    if (grid < 0) return;
    Args a{};
    for (int i = 0; i < 21; ++i) a.in[i] = (const float*)d_in[i];
    a.out = (float*)d_out; a.ws = (unsigned char*)d_ws;
#if MK_ONE_LAUNCH
    a.ph_lo = 0; a.ph_hi = NPH;
    void* args[] = {&a};
    hipError_t e = hipLaunchCooperativeKernel((const void*)mk_fwd, dim3(grid), dim3(NTHR), args, LDS_BYTES, stream);
    if (e != hipSuccess) fprintf(stderr, "cooperative launch failed: %s (grid %d)\n", hipGetErrorString(e), grid);
#else
    for (int ph = 0; ph < NPH; ++ph) {
        a.ph_lo = ph; a.ph_hi = ph + 1;
        hipLaunchKernelGGL(mk_fwd, dim3(grid), dim3(NTHR), LDS_BYTES, stream, a);
    }
#endif
}
```

```cpp
#include <hip/hip_runtime.h>
#include <hip/hip_cooperative_groups.h>
#include <cstdio>
#include <cstdint>
namespace cg = cooperative_groups;

#ifndef MK_ONE_LAUNCH
#define MK_ONE_LAUNCH 1
#endif

#define LAS __attribute__((address_space(3)))
typedef unsigned short bf16_t;
typedef short bf16x8 __attribute__((ext_vector_type(8)));
typedef float f32x4 __attribute__((ext_vector_type(4)));
typedef unsigned u32x4 __attribute__((ext_vector_type(4)));
typedef unsigned u32x2 __attribute__((ext_vector_type(2)));

constexpr int NB = 8, SEQ = 4096, DM = 1024, MT = NB * SEQ, INW = 6400, DFF = 2816, DEPTH = 2;
constexpr float EPS = 1e-6f;
constexpr float LOG2E = 1.4426950408889634f;
constexpr float C2 = 0.125f * LOG2E;
constexpr int NWAVES = 8, NTHR = 512;
constexpr size_t MiB = 1u << 20;
constexpr size_t WS_ROT = 1 * MiB;
constexpr size_t WS_BT = 2 * MiB;
constexpr size_t WS_LAM = 2 * MiB + 4096;
constexpr size_t WS_RS = 3 * MiB;
constexpr size_t WS_WIN = 4 * MiB;
constexpr size_t WS_WBR = WS_WIN + (size_t)INW * DM * 2;
constexpr size_t WS_WOUT = WS_WBR + 2 * MiB;
constexpr size_t WS_WFFI = WS_WOUT + 2 * MiB;
constexpr size_t WS_WFFO = WS_WFFI + (size_t)2 * DFF * DM * 2;
constexpr size_t WS_XB = 38 * MiB;
constexpr size_t WS_R = 102 * MiB;
constexpr size_t R_Q = 0, R_K = 32 * MiB, R_V = 64 * MiB, R_RQ = 96 * MiB, R_RK = 112 * MiB, R_RV = 128 * MiB, R_RG = 144 * MiB,
                 R_SCB = 160 * MiB, R_SCC = 176 * MiB, R_SCX = 192 * MiB, R_GATES = 208 * MiB;
constexpr size_t R_OCAT = 0, R_Y = 64 * MiB, R_G = 0, R_U = 176 * MiB;
constexpr size_t WS_KV = 502 * MiB;
constexpr size_t WS_SSQ = 510 * MiB;
constexpr size_t WS_END = 512 * MiB;
constexpr size_t WS_HX = 256 * 1024;
constexpr size_t WS_PART = WS_KV;
static_assert(WS_WFFO + (size_t)DM * DFF * 2 <= WS_XB, "weights fit");

constexpr int LDS_BYTES = 147456;

#define LDS_WAIT() asm volatile("s_waitcnt lgkmcnt(0)" ::: "memory")

__device__ __forceinline__ unsigned cvt_pk_bf16(float lo, float hi) { unsigned r; asm volatile("v_cvt_pk_bf16_f32 %0, %1, %2" : "=v"(r) : "v"(lo), "v"(hi)); return r; }
__device__ __forceinline__ float bflo(unsigned w) { return __uint_as_float(w << 16); }
__device__ __forceinline__ float bfhi(unsigned w) { return __uint_as_float(w & 0xffff0000u); }
__device__ __forceinline__ float bf2f(bf16_t b) { return __uint_as_float((unsigned)b << 16); }
__device__ __forceinline__ float sigmoidf_(float v) { return __builtin_amdgcn_rcpf(1.f + __expf(-v)); }

__device__ __forceinline__ float row_scale(const float* ssq, int row) {
    const f32x4* p = (const f32x4*)(ssq + (size_t)row * 16); const f32x4 a = p[0], b = p[1], c = p[2], d = p[3];
    const float s = ((a.x + a.y) + (a.z + a.w)) + ((b.x + b.y) + (b.z + b.w)) + ((c.x + c.y) + (c.z + c.w)) + ((d.x + d.y) + (d.z + d.w));
    return rsqrtf(s * (1.f / DM) + EPS);
}

namespace pg8 {
constexpr int BM = 256, BK = 64, HALF = 128, HTB = HALF * BK * 2, STAGE_BYTES = 8 * HTB, NXCD = 8, WGM = 4;
__host__ __device__ __forceinline__ int lds_byte(int r, int c) { const int st = (r >> 4) * 2 + (c >> 5), rr = r & 15, cc = c & 31, ob = rr * 64 + cc * 2; return st * 1024 + (ob ^ (((ob >> 9) & 1) << 5)); }
__host__ __device__ __forceinline__ void stage_rc(int b, int& R, int& C) { const int st = b / 1024, sb = b % 1024, swz = sb ^ (((sb >> 9) & 1) << 5); R = (st >> 1) * 16 + swz / 64; C = (st & 1) * 32 + (swz % 64) / 2; }
__host__ __device__ __forceinline__ int perm32(int rho) { const int n = rho >> 4, i = rho & 15; return 8 * (i >> 2) + 4 * n + (i & 3); }

struct Unit { int pm, pn, koff, nt, seg; };
struct Gemm { const bf16_t* A; const bf16_t* Bt; int pitch; };

struct Order {
    int nM, nN, nwg, G, c, nseg, nt0;
    __device__ void init(int M, int N, int G_, int c_, int nseg_, int nt0_) { nM = M / BM; nN = N / BM; nwg = nM * nN; G = G_; c = c_; nseg = nseg_; nt0 = nt0_; }
    __device__ bool next(int i, Unit& u) const {
        int tile = i, seg = 0;
        if (nseg == 3) { tile = i / 3; seg = i - tile * 3; }
        const long L = (long)tile * G + c; if (L >= nwg) return false;
        int wgid = (int)L; { const int q = nwg / NXCD, r = nwg % NXCD, xcd = wgid % NXCD, off = wgid / NXCD; wgid = (xcd < r ? xcd * (q + 1) : r * (q + 1) + (xcd - r) * q) + off; }
        const int nig = WGM * nN, gid = wgid / nig, fm = gid * WGM, gsz = (nM - fm) < WGM ? (nM - fm) : WGM;
        u.pm = fm + ((wgid % nig) % gsz); u.pn = (wgid % nig) / gsz; u.seg = seg;
        if (nseg == 3) { u.koff = seg == 0 ? 0 : (seg == 1 ? 512 : 768); u.nt = seg == 0 ? 8 : 4; }
        else { u.koff = 0; u.nt = nt0; }
        return true;
    }
};

template <class Epi, class Sched>
__device__ __forceinline__ void gemm_phase(LAS unsigned char* lds, const Gemm g, const Sched& S, const Epi& E, const int tid) {
    const int wid = __builtin_amdgcn_readfirstlane(tid >> 6), lane = tid & 63, wr = wid >> 2, wc = wid & 3, fr = lane & 15, fq = lane >> 4;
    const int P = g.pitch;
    unsigned voffA[2], voffB[2];
#pragma unroll
    for (int i = 0; i < 2; ++i) { int R, C; stage_rc(tid * 16 + i * 8192, R, C); const int Rb = Epi::PERM ? ((R & ~31) + perm32(R & 31)) : R;
        voffA[i] = (unsigned)(R * P + C) * 2u; voffB[i] = (unsigned)(Rb * P + C) * 2u; }
    const size_t kstep = (size_t)(BK * 2);
    const size_t hstep = (size_t)HALF * P * 2;
    const size_t tstep = 2 * hstep;
    const unsigned ldsw = (unsigned)wid * 1024u;
    const int aoff = lds_byte(wr * 64 + fr, fq * 8), boff = lds_byte(wc * 32 + fr, fq * 8);
#define PG8_SA(b, h) (((b) * 2 + (h)) * HTB)
#define PG8_SB(b, h) ((4 + (b) * 2 + (h)) * HTB)
#define PG8_STAGE(bufoff, gbase, voff) do { _Pragma("unroll") for (int _i = 0; _i < 2; ++_i) \
        __builtin_amdgcn_global_load_lds((const unsigned*)((const char*)(gbase) + (voff)[_i]), (LAS unsigned*)(lds + (bufoff) + ldsw + _i * 8192), 16, 0, 0); } while (0)
#define PG8_LDA(dst, b, h) do { _Pragma("unroll") for (int m = 0; m < 4; ++m) _Pragma("unroll") for (int k = 0; k < 2; ++k) dst[m][k] = *(const LAS bf16x8*)(lds + PG8_SA(b, h) + aoff + m * 2048 + k * 1024); } while (0)
#define PG8_LDB(dst, b, h) do { _Pragma("unroll") for (int n = 0; n < 2; ++n) _Pragma("unroll") for (int k = 0; k < 2; ++k) dst[n][k] = *(const LAS bf16x8*)(lds + PG8_SB(b, h) + boff + n * 2048 + k * 1024); } while (0)
#define PG8_MMA(ai, bj, At, Bt) do { __builtin_amdgcn_s_setprio(1); _Pragma("unroll") for (int m = 0; m < 4; ++m) _Pragma("unroll") for (int n = 0; n < 2; ++n) _Pragma("unroll") for (int k = 0; k < 2; ++k) \
        acc[ai][bj][m][n] = __builtin_amdgcn_mfma_f32_16x16x32_bf16(Bt[n][k], At[m][k], acc[ai][bj][m][n], 0, 0, 0); __builtin_amdgcn_s_setprio(0); } while (0)
#define PG8_WAIT_V(n) asm volatile("s_waitcnt vmcnt(" #n ")" ::: "memory")
#define PG8_WAIT_L(n) asm volatile("s_waitcnt lgkmcnt(" #n ")" ::: "memory")
#define PG8_BAR __builtin_amdgcn_s_barrier()
#define PG8_SCHED __builtin_amdgcn_sched_barrier(0)
    Unit cur, nxt; int ui = 0;
    if (!S.next(0, cur)) return;
    f32x4 acc[2][2][4][2];
#pragma unroll
    for (int a = 0; a < 2; ++a)
#pragma unroll
        for (int b = 0; b < 2; ++b)
#pragma unroll
            for (int m = 0; m < 4; ++m)
#pragma unroll
                for (int n = 0; n < 2; ++n) acc[a][b][m][n] = (f32x4){0.f, 0.f, 0.f, 0.f};
    bf16x8 At[4][2], B0[2][2], B1[2][2];
    const char* cA = (const char*)g.A + (size_t)cur.pm * tstep + (size_t)cur.koff * 2; const char* cB = (const char*)g.Bt + (size_t)cur.pn * tstep + (size_t)cur.koff * 2;
    E.prep(cur, lds + STAGE_BYTES, tid);
    PG8_STAGE(PG8_SB(0, 0), cB, voffB); PG8_STAGE(PG8_SB(0, 1), cB + hstep, voffB); PG8_STAGE(PG8_SA(0, 0), cA, voffA); PG8_STAGE(PG8_SA(0, 1), cA + hstep, voffA);
    if (wr == 1) PG8_BAR;
    PG8_WAIT_V(2); PG8_BAR;
    PG8_STAGE(PG8_SB(1, 0), cB + kstep, voffB); PG8_STAGE(PG8_SA(1, 0), cA + kstep, voffA); PG8_STAGE(PG8_SB(1, 1), cB + hstep + kstep, voffB);
    PG8_WAIT_V(6); PG8_BAR;
    for (;;) {
        const bool has_next = S.next(ui + 1, nxt);
        const char* nA = has_next ? (const char*)g.A + (size_t)nxt.pm * tstep + (size_t)nxt.koff * 2 : cA; const char* nB = has_next ? (const char*)g.Bt + (size_t)nxt.pn * tstep + (size_t)nxt.koff * 2 : cB;
        const int nt = cur.nt;
        for (int t = 0; t < nt; t += 2) {
            if constexpr (Epi::CHAIN) { if (t == 8 || t == 12) { E.mid(acc, cur, t == 8 ? 0 : 1, wr, wc, fr, fq); PG8_SCHED; } }
            const bool last = (t == nt - 2);
            const char* a1 = cA + (size_t)(t + 1) * kstep;
            const char* a2 = last ? nA : cA + (size_t)(t + 2) * kstep; const char* b2 = last ? nB : cB + (size_t)(t + 2) * kstep;
            const char* a3 = a2 + kstep; const char* b3 = b2 + kstep;
            PG8_LDB(B0, 0, 0); PG8_LDB(B1, 0, 1); PG8_SCHED; PG8_LDA(At, 0, 0); PG8_STAGE(PG8_SA(1, 1), a1 + hstep, voffA);
            PG8_WAIT_V(8); PG8_WAIT_L(0); PG8_BAR; PG8_MMA(0, 0, At, B0); PG8_MMA(0, 1, At, B1); PG8_BAR; PG8_SCHED;
            PG8_LDA(At, 0, 1); PG8_STAGE(PG8_SB(0, 0), b2, voffB); PG8_STAGE(PG8_SB(0, 1), b2 + hstep, voffB); PG8_STAGE(PG8_SA(0, 0), a2, voffA);
            PG8_WAIT_V(8); PG8_WAIT_L(0); PG8_BAR; PG8_MMA(1, 0, At, B0); PG8_MMA(1, 1, At, B1); PG8_BAR; PG8_SCHED;
            PG8_LDB(B0, 1, 0); PG8_LDB(B1, 1, 1); PG8_SCHED; PG8_LDA(At, 1, 0); PG8_STAGE(PG8_SA(0, 1), a2 + hstep, voffA);
            PG8_WAIT_V(8); PG8_WAIT_L(0); PG8_BAR; PG8_MMA(0, 0, At, B0); PG8_MMA(0, 1, At, B1); PG8_BAR; PG8_SCHED;
            PG8_LDA(At, 1, 1); PG8_STAGE(PG8_SB(1, 0), b3, voffB); PG8_STAGE(PG8_SB(1, 1), b3 + hstep, voffB); PG8_STAGE(PG8_SA(1, 0), a3, voffA);
            PG8_WAIT_V(8); PG8_WAIT_L(0); PG8_BAR; PG8_MMA(1, 0, At, B0); PG8_MMA(1, 1, At, B1); PG8_BAR; PG8_SCHED;
        }
        if (wr == 0) PG8_BAR;
        E(acc, cur, wr, wc, fr, fq, lds + STAGE_BYTES + (ui & 1) * 2048);
        if (!has_next) break;
        if (!(Epi::CHAIN && nxt.seg != 0))
#pragma unroll
        for (int a = 0; a < 2; ++a)
#pragma unroll
            for (int b = 0; b < 2; ++b)
#pragma unroll
                for (int m = 0; m < 4; ++m)
#pragma unroll
                    for (int n = 0; n < 2; ++n) acc[a][b][m][n] = (f32x4){0.f, 0.f, 0.f, 0.f};
        cur = nxt; cA = nA; cB = nB; ++ui;
        E.prep(cur, lds + STAGE_BYTES + (ui & 1) * 2048, tid);
        if (wr == 1) PG8_BAR;
    }
    PG8_WAIT_V(0);
    PG8_BAR;
#undef PG8_SA
#undef PG8_SB
#undef PG8_STAGE
#undef PG8_LDA
#undef PG8_LDB
#undef PG8_MMA
#undef PG8_WAIT_V
#undef PG8_WAIT_L
#undef PG8_BAR
#undef PG8_SCHED
}
}

template <int MODE> struct EpiSplit {
    static constexpr bool PERM = true, CHAIN = false;
    unsigned char* R; const float* ssq; const float* bgate; const float* qg; const float* kg; const float* rot;
    __device__ __forceinline__ void prep(const pg8::Unit& u, LAS unsigned char* sp, int tid) const {
        if (tid < 256) ((LAS float*)sp)[tid] = row_scale(ssq, u.pm * 256 + tid);
        else if (MODE == 0 && u.pn >= 13) ((LAS float*)sp)[tid] = bgate[(u.pn - 13) * 256 + (tid - 256)];
    }
    __device__ __forceinline__ void operator()(const f32x4 (&acc)[2][2][4][2], const pg8::Unit& u, int wr, int wc, int fr, int fq, LAS unsigned char* sp) const {
        const LAS float* rsl = (const LAS float*)sp + wr * 64 + fr; const LAS float* bsl = (const LAS float*)sp + 256;
        const int pn = u.pn; bf16_t* dst; int pitch, colt, act = 0;
        if (MODE == 0) {
            if (pn < 6) { dst = (bf16_t*)(R + (size_t)(pn >> 1) * (32 * MiB)); pitch = 512; colt = (pn & 1) * 256; act = (pn < 4) ? 3 : 0; }
            else if (pn < 13) { dst = (bf16_t*)(R + R_RQ + (size_t)(pn - 6) * (16 * MiB)); pitch = 256; colt = 0; act = (pn == 9) ? 1 : ((pn < 8) ? 4 : 0); }
            else { dst = (bf16_t*)(R + R_GATES); pitch = 3072; colt = (pn - 13) * 256; act = 2; }
        } else {
            if (pn < 11) { dst = (bf16_t*)(R + R_G); colt = pn * 256; } else { dst = (bf16_t*)(R + R_U); colt = (pn - 11) * 256; }
            pitch = DFF;
        }
        const int row0 = u.pm * 256 + wr * 64 + fr;
        if (MODE == 0 && act >= 3) {
            const int cwh = 64 * wc + 8 * fq;
            const float* gn = (pn < 2) ? qg : kg; const float osc = (pn < 2) ? C2 : ((pn == 7) ? 0.125f : 1.f);
#pragma unroll
            for (int ai = 0; ai < 2; ++ai)
#pragma unroll
                for (int m = 0; m < 4; ++m) {
                    const int row = row0 + ai * 128 + m * 16; const float s = rsl[ai * 128 + m * 16];
                    f32x4 v[2][2];
#pragma unroll
                    for (int bj = 0; bj < 2; ++bj)
#pragma unroll
                        for (int n = 0; n < 2; ++n) v[bj][n] = acc[ai][bj][m][n] * s;
                    if (act == 3) {
                        float q = 0.f;
#pragma unroll
                        for (int bj = 0; bj < 2; ++bj)
#pragma unroll
                            for (int n = 0; n < 2; ++n) q += (v[bj][n][0] * v[bj][n][0] + v[bj][n][1] * v[bj][n][1]) + (v[bj][n][2] * v[bj][n][2] + v[bj][n][3] * v[bj][n][3]);
                        q += __shfl_xor(q, 16); q += __shfl_xor(q, 32);
                        const float ri = rsqrtf(q * (1.f / 64.f) + EPS) * osc;
#pragma unroll
                        for (int bj = 0; bj < 2; ++bj)
#pragma unroll
                            for (int n = 0; n < 2; ++n) { const f32x4 g = *(const f32x4*)(gn + 32 * bj + 8 * fq + 4 * n); v[bj][n] = v[bj][n] * g * ri; }
                    } else {
                        const int pos = row & (SEQ - 1);
#pragma unroll
                        for (int n = 0; n < 2; ++n) { const f32x4 cs = *(const f32x4*)(rot + pos * 32 + 8 * fq + 4 * n), sn = *(const f32x4*)(rot + 4096 * 32 + pos * 32 + 8 * fq + 4 * n);
                            const f32x4 x1 = v[0][n], x2 = v[1][n]; v[0][n] = (x1 * cs - x2 * sn) * osc; v[1][n] = (x2 * cs + x1 * sn) * osc; }
                    }
#pragma unroll
                    for (int bj = 0; bj < 2; ++bj) { u32x4 w; w.x = cvt_pk_bf16(v[bj][0][0], v[bj][0][1]); w.y = cvt_pk_bf16(v[bj][0][2], v[bj][0][3]); w.z = cvt_pk_bf16(v[bj][1][0], v[bj][1][1]); w.w = cvt_pk_bf16(v[bj][1][2], v[bj][1][3]);
                        *(u32x4*)(dst + (size_t)row * pitch + colt + cwh + 32 * bj) = w; }
                }
            return;
        }
        const int cw0 = wc * 32 + 8 * fq;
#pragma unroll
        for (int ai = 0; ai < 2; ++ai)
#pragma unroll
            for (int m = 0; m < 4; ++m) {
                const int row = row0 + ai * 128 + m * 16; const float s = rsl[ai * 128 + m * 16];
#pragma unroll
                for (int bj = 0; bj < 2; ++bj) {
                    f32x4 v0 = acc[ai][bj][m][0] * s, v1 = acc[ai][bj][m][1] * s;
                    const int col = colt + bj * 128 + cw0;
                    if (act == 2) { const f32x4 b0 = *(const LAS f32x4*)(bsl + bj * 128 + cw0), b1 = *(const LAS f32x4*)(bsl + bj * 128 + cw0 + 4);
                        v0 += b0; v1 += b1;
#pragma unroll
                        for (int j = 0; j < 4; ++j) { v0[j] = sigmoidf_(v0[j]); v1[j] = sigmoidf_(v1[j]); } }
                    else if (act == 1) {
#pragma unroll
                        for (int j = 0; j < 4; ++j) { v0[j] = v0[j] * sigmoidf_(v0[j]); v1[j] = v1[j] * sigmoidf_(v1[j]); } }
                    u32x4 w; w.x = cvt_pk_bf16(v0[0], v0[1]); w.y = cvt_pk_bf16(v0[2], v0[3]); w.z = cvt_pk_bf16(v1[0], v1[1]); w.w = cvt_pk_bf16(v1[2], v1[3]);
                    *(u32x4*)(dst + (size_t)row * pitch + col) = w;
                }
            }
    }
};
struct EpiAcc {
    static constexpr bool PERM = true, CHAIN = true;
    const bf16_t* gates; bf16_t* Y;
    __device__ __forceinline__ void mid(f32x4 (&acc)[2][2][4][2], const pg8::Unit& u, int seg, int wr, int wc, int fr, int fq) const {
        asm volatile("" : "+v"(fr), "+v"(fq));
        const int row0 = u.pm * 256 + wr * 64 + fr, col0 = u.pn * 256 + wc * 32 + 8 * fq;
#pragma unroll
        for (int ai = 0; ai < 2; ++ai)
#pragma unroll
            for (int m = 0; m < 4; ++m) {
                const bf16_t* gp = gates + (size_t)(row0 + ai * 128 + m * 16) * 3072 + seg * 1024 + col0;
#pragma unroll
                for (int bj = 0; bj < 2; ++bj) {
                    const u32x4 gw = *(const u32x4*)(gp + bj * 128), hw = *(const u32x4*)(gp + 1024 + bj * 128);
                    f32x4 v0 = acc[ai][bj][m][0], v1 = acc[ai][bj][m][1];
                    v0[0] *= bflo(gw.x) * __builtin_amdgcn_rcpf(fmaxf(bflo(hw.x), 1e-20f)); v0[1] *= bfhi(gw.x) * __builtin_amdgcn_rcpf(fmaxf(bfhi(hw.x), 1e-20f));
                    v0[2] *= bflo(gw.y) * __builtin_amdgcn_rcpf(fmaxf(bflo(hw.y), 1e-20f)); v0[3] *= bfhi(gw.y) * __builtin_amdgcn_rcpf(fmaxf(bfhi(hw.y), 1e-20f));
                    v1[0] *= bflo(gw.z) * __builtin_amdgcn_rcpf(fmaxf(bflo(hw.z), 1e-20f)); v1[1] *= bfhi(gw.z) * __builtin_amdgcn_rcpf(fmaxf(bfhi(hw.z), 1e-20f));
                    v1[2] *= bflo(gw.w) * __builtin_amdgcn_rcpf(fmaxf(bflo(hw.w), 1e-20f)); v1[3] *= bfhi(gw.w) * __builtin_amdgcn_rcpf(fmaxf(bfhi(hw.w), 1e-20f));
                    acc[ai][bj][m][0] = v0; acc[ai][bj][m][1] = v1;
                }
                if (m & 1) asm volatile("" ::: "memory");
            }
    }
    __device__ __forceinline__ void prep(const pg8::Unit&, LAS unsigned char*, int) const {}
    __device__ __forceinline__ void operator()(f32x4 (&acc)[2][2][4][2], const pg8::Unit& u, int wr, int wc, int fr, int fq, LAS unsigned char*) const {
        const int row0 = u.pm * 256 + wr * 64 + fr, col0 = u.pn * 256 + wc * 32 + 8 * fq;
#pragma unroll
        for (int ai = 0; ai < 2; ++ai)
#pragma unroll
            for (int m = 0; m < 4; ++m) {
                const int row = row0 + ai * 128 + m * 16;
#pragma unroll
                for (int bj = 0; bj < 2; ++bj) {
                    const int col = col0 + bj * 128;
                    const u32x4 gw = *(const u32x4*)(gates + (size_t)row * 3072 + 2048 + col);
                    const f32x4 v0 = acc[ai][bj][m][0], v1 = acc[ai][bj][m][1];
                    u32x4 w; w.x = cvt_pk_bf16(v0[0] * bflo(gw.x), v0[1] * bfhi(gw.x)); w.y = cvt_pk_bf16(v0[2] * bflo(gw.y), v0[3] * bfhi(gw.y));
                    w.z = cvt_pk_bf16(v1[0] * bflo(gw.z), v1[1] * bfhi(gw.z)); w.w = cvt_pk_bf16(v1[2] * bflo(gw.w), v1[3] * bfhi(gw.w));
                    *(u32x4*)(Y + (size_t)row * DM + col) = w;
                }
            }
    }
};
struct EpiRes {
    static constexpr bool PERM = false, CHAIN = false;
    const float* xin; float* xout; bf16_t* xb; float* ssq;
    __device__ __forceinline__ void prep(const pg8::Unit&, LAS unsigned char*, int) const {}
    __device__ __forceinline__ void operator()(const f32x4 (&acc)[2][2][4][2], const pg8::Unit& u, int wr, int wc, int fr, int fq, LAS unsigned char*) const {
        const int row0 = u.pm * 256 + wr * 64 + fr, col0 = u.pn * 256 + wc * 32 + 4 * fq;
#pragma unroll
        for (int ai = 0; ai < 2; ++ai)
#pragma unroll
            for (int m = 0; m < 4; ++m) {
                const int row = row0 + ai * 128 + m * 16; const size_t off = (size_t)row * DM + col0; float q = 0.f;
#pragma unroll
                for (int bj = 0; bj < 2; ++bj)
#pragma unroll
                    for (int n = 0; n < 2; ++n) { const size_t o = off + bj * 128 + n * 16; const f32x4 xv = *(const f32x4*)(xin + o) + acc[ai][bj][m][n]; *(f32x4*)(xout + o) = xv;
                        q += (xv[0] * xv[0] + xv[1] * xv[1]) + (xv[2] * xv[2] + xv[3] * xv[3]);
                        u32x2 w; w.x = cvt_pk_bf16(xv[0], xv[1]); w.y = cvt_pk_bf16(xv[2], xv[3]); *(u32x2*)(xb + o) = w; }
                q += __shfl_xor(q, 16); q += __shfl_xor(q, 32);
                if (fq == 0) ssq[(size_t)row * 16 + u.pn * 4 + wc] = q;
            }
    }
};

struct Args { const float* in[21]; float* out; unsigned char* ws; int ph_lo, ph_hi; };
typedef const __attribute__((address_space(4))) Args CArgs;
enum { I_X = 0, I_RELB, I_NMG, I_WIN, I_BGATE, I_QG, I_KG, I_LAM, I_SUBLN, I_RETG, I_SCW, I_SCB, I_WDA, I_WRET, I_WSC, I_WOUT, I_NFG, I_WFFI, I_FCW, I_FCB, I_WFFO };

__device__ __forceinline__ float wave_sum(float v) {
#pragma unroll
    for (int o = 1; o < 64; o <<= 1) v += __shfl_xor(v, o);
    return v;
}

__device__ __forceinline__ void transpose_item(const float* W, int N, const float* gain, bf16_t* WT, int dpitch, int dcol, LAS float* scr, int item, int lane, const bool headperm = false) {
    const int nblk = N / 32, kb = item / nblk, nb = item % nblk, k0 = 64 * kb, n0 = 32 * nb;
#pragma unroll
    for (int i = 0; i < 8; ++i) { const int kk = 8 * i + (lane >> 3), n4 = (lane & 7) * 4;
        f32x4 w = *(const f32x4*)(W + (size_t)(k0 + kk) * N + n0 + n4); if (gain) w *= gain[k0 + kk];
        LAS float* d = scr + kk * 33 + n4; d[0] = w.x; d[1] = w.y; d[2] = w.z; d[3] = w.w; }
    LDS_WAIT(); asm volatile("" ::: "memory");
    const int c = lane & 7;
#pragma unroll
    for (int j = 0; j < 4; ++j) { const int n = (lane >> 3) + 8 * j; const LAS float* s = scr + (8 * c) * 33 + n;
        u32x4 o; o.x = cvt_pk_bf16(s[0 * 33], s[1 * 33]); o.y = cvt_pk_bf16(s[2 * 33], s[3 * 33]); o.z = cvt_pk_bf16(s[4 * 33], s[5 * 33]); o.w = cvt_pk_bf16(s[6 * 33], s[7 * 33]);
        int nr = n0 + n;
        if (headperm && (nr < 1024 || (nr >= 1536 && nr < 2048))) { const int L = nr & 255; nr = (nr & ~255) + 128 * ((L >> 5) & 1) + 32 * (L >> 6) + (L & 31); }
        *(u32x4*)(WT + (size_t)nr * dpitch + dcol + k0 + 8 * c) = o; }
    LDS_WAIT(); asm volatile("" ::: "memory");
}
__device__ __forceinline__ int rel_bucket(int n) {
    if (n < 16) return n;
    const float v = logf((float)n / 16.f) / 2.0794415416798357f * 16.f;
    const int b = 16 + (int)v; return b < 31 ? b : 31;
}
__device__ __forceinline__ void xpass(const float* x, bf16_t* xb, float* rs, int gw, int NGW, int lane) {
    for (int m = gw; m < MT; m += NGW) {
        const f32x4* xr = (const f32x4*)(x + (size_t)m * DM) + lane;
        f32x4 v[4]; float s = 0.f;
#pragma unroll
        for (int j = 0; j < 4; ++j) { v[j] = xr[64 * j]; s += (v[j].x * v[j].x + v[j].y * v[j].y) + (v[j].z * v[j].z + v[j].w * v[j].w); }
        s = wave_sum(s);
        if (lane < 16) rs[(size_t)m * 16 + lane] = (lane == 0) ? s : 0.f;
        u32x2* o = (u32x2*)(xb + (size_t)m * DM) + lane;
#pragma unroll
        for (int j = 0; j < 4; ++j) { u32x2 w; w.x = cvt_pk_bf16(v[j].x, v[j].y); w.y = cvt_pk_bf16(v[j].z, v[j].w); o[64 * j] = w; }
    }
}
__device__ __forceinline__ void phase_W(CArgs& a, int l, LAS unsigned char* lds, const int tid, const int bx, const int G) {
    unsigned char* ws = a.ws;
    const int lane = tid & 63, wave = tid >> 6;
    const int gw = bx * NWAVES + wave, NGW = G * NWAVES;
    LAS float* scr = (LAS float*)(lds + wave * 16384);
    constexpr int I0 = 16 * 200, I1 = 8 * 32, I2 = 4 * 32, I3 = 4 * 32, I4 = 16 * 32, I5 = 16 * 176, I6 = 44 * 32;
    constexpr int NITEMS = I0 + I1 + I2 + I3 + I4 + I5 + I6;
    for (int it = gw; it < NITEMS; it += NGW) {
        int r = it;
        if (r < I0) { transpose_item(a.in[I_WIN] + (size_t)l * DM * INW, INW, a.in[I_NMG] + l * DM, (bf16_t*)(ws + WS_WIN), DM, 0, scr, r, lane, true); continue; } r -= I0;
        if (r < I1) { transpose_item(a.in[I_WDA] + (size_t)l * 512 * DM, DM, nullptr, (bf16_t*)(ws + WS_WBR), DM, 0, scr, r, lane); continue; } r -= I1;
        if (r < I2) { transpose_item(a.in[I_WRET] + (size_t)l * 256 * DM, DM, nullptr, (bf16_t*)(ws + WS_WBR), DM, 512, scr, r, lane); continue; } r -= I2;
        if (r < I3) { transpose_item(a.in[I_WSC] + (size_t)l * 256 * DM, DM, nullptr, (bf16_t*)(ws + WS_WBR), DM, 768, scr, r, lane); continue; } r -= I3;
        if (r < I4) { transpose_item(a.in[I_WOUT] + (size_t)l * DM * DM, DM, nullptr, (bf16_t*)(ws + WS_WOUT), DM, 0, scr, r, lane); continue; } r -= I4;
        if (r < I5) { transpose_item(a.in[I_WFFI] + (size_t)l * DM * 2 * DFF, 2 * DFF, a.in[I_NFG] + l * DM, (bf16_t*)(ws + WS_WFFI), DM, 0, scr, r, lane); continue; } r -= I5;
        transpose_item(a.in[I_WFFO] + (size_t)l * DFF * DM, DM, nullptr, (bf16_t*)(ws + WS_WFFO), DFF, 0, scr, r, lane);
    }
    {
        LAS float* xs = (LAS float*)(lds + wave * 16384);
        const float* xsrc = (l == 0 ? a.in[I_X] : a.out);
        float* part = (float*)(ws + WS_PART);
        if ((gw & 3) == 0)
        for (int it = gw >> 2; it < 512; it += (NGW + 3) >> 2) {
            const int cg = it & 15, kc = it >> 4, k0 = kc * 32;
            { const f32x4* xr = (const f32x4*)(xsrc + ((size_t)(lane >> 3) * SEQ + (lane & 7)) * DM + k0);
#pragma unroll
              for (int i = 0; i < 8; ++i) { const f32x4 v = xr[i]; *(LAS f32x4*)(xs + lane * 36 + 4 * i) = v; } }
            float w[32];
            { const float* Wl = a.in[I_WIN] + (size_t)l * DM * INW + (size_t)k0 * INW + 1536 + cg * 64 + lane; const float* gm = a.in[I_NMG] + l * DM + k0;
#pragma unroll
              for (int kk = 0; kk < 32; ++kk) w[kk] = Wl[(size_t)kk * INW] * gm[kk]; }
            LDS_WAIT(); asm volatile("" ::: "memory");
#pragma unroll 4
            for (int r = 0; r < 64; ++r) { float acc = 0.f;
#pragma unroll
                for (int k4 = 0; k4 < 8; ++k4) { const f32x4 xv = *(const LAS f32x4*)(xs + r * 36 + 4 * k4); acc += xv.x * w[4 * k4] + xv.y * w[4 * k4 + 1] + xv.z * w[4 * k4 + 2] + xv.w * w[4 * k4 + 3]; }
                part[((size_t)kc * 64 + r) * 1024 + cg * 64 + lane] = acc; }
            LDS_WAIT(); asm volatile("" ::: "memory");
        }
    }
    const int gt = bx * NTHR + tid, NGT = G * NTHR;
    if (l == 0) {
        float* ct = (float*)(ws + WS_ROT); float* st = ct + 4096 * 32;
        for (int e = gt; e < 4096 * 32; e += NGT) {
            const int pos = e >> 5, i = e & 31;
            const float inv = exp2f(-(float)i * 0.41524101186092029f);
            const float ang = (float)pos * inv;
            const float kq = rintf(ang * 0.15915494309189535f);
            float rr = fmaf(-kq, 6.28125f, ang); rr = fmaf(-kq, 0.0019353071795864769f, rr);
            const float rev = rr * 0.15915494309189535f;
            ct[e] = __builtin_amdgcn_cosf(rev); st[e] = __builtin_amdgcn_sinf(rev);
        }
        float* bt = (float*)(ws + WS_BT);
        if (gt < 512) { const int h = gt >> 7, d = gt & 127; const float* rb = a.in[I_RELB];
            bt[gt] = (rb[rel_bucket(d) * 4 + h] - rb[31 * 4 + h]) * LOG2E; }
    }
    if (gt == 0) {
        const float* lp = a.in[I_LAM] + l * 256; float s1 = 0.f, s2 = 0.f;
        for (int i = 0; i < 64; ++i) { s1 += lp[i] * lp[64 + i]; s2 += lp[128 + i] * lp[192 + i]; }
        ((float*)(ws + WS_LAM))[l] = expf(s1) - expf(s2) + (0.8f - 0.6f * expf(-0.3f * (float)l));
    }
    if (l == 0) xpass(a.in[I_X], (bf16_t*)(ws + WS_XB), (float*)(ws + WS_SSQ), gw, NGW, lane);
}

__device__ __forceinline__ void reduce_hx(unsigned char* ws, const int tid, const int bx, const int G) {
    const f32x4* part = (const f32x4*)(ws + WS_PART); f32x4* hx = (f32x4*)(ws + WS_HX);
    for (int e = bx * NTHR + tid; e < 64 * 1024 / 4; e += G * NTHR) { f32x4 s = (f32x4){0.f, 0.f, 0.f, 0.f};
#pragma unroll 16
        for (int kc = 0; kc < 32; ++kc) s += part[(size_t)kc * 16384 + e];
        hx[e] = s; }
}

#include <hip/hip_bf16.h>
#include <cmath>
namespace attn_body {
using bf16=__hip_bfloat16;
using bf16x8=__attribute__((ext_vector_type(8)))short;
using s16x4=__attribute__((ext_vector_type(4)))short;
using f32x16=__attribute__((ext_vector_type(16)))float;
using u32x4=__attribute__((ext_vector_type(4)))unsigned;
constexpr int SEQ=4096,D=64,QP=512,KP=512,VP=512,OP=1024;
constexpr int NW=8,QBLK=32,QB=QBLK*NW,KVBLK=64,NQB=SEQ/QB;
__device__ __forceinline__ int crow(int r,int hi){return (r&3)+8*(r>>2)+4*hi;}
#define SBAR() __builtin_amdgcn_sched_barrier(0)
__device__ __forceinline__ void cmask(f32x16&p0,f32x16&p1,int jb,int qrel,int hi){
  const float NEG=-INFINITY; int kb=64*jb+4*hi;
  #pragma unroll
  for(int r=0;r<16;++r){int kv=kb+(r&3)+8*(r>>2); if(kv>qrel)p0[r]=NEG; if(kv+32>qrel)p1[r]=NEG;}
}

typedef __attribute__((address_space(3))) const float* lds_fptr;
__device__ __forceinline__ void biasmask(f32x16&p0,f32x16&p1,int jb,int qrel,int hi,lds_fptr Tl){
  const float NEG=-INFINITY; const int d00=qrel-(64*jb+4*hi);
  #pragma unroll
  for(int g=0;g<4;++g){
    #pragma unroll
    for(int q=0;q<4;++q){const int r=4*g+q; const int d0=d00-(q+8*g),d1=d0-32;
      const int i0=d0<0?0:(d0>127?127:d0),i1=d1<0?0:(d1>127?127:d1);
      const float b0=Tl[i0],b1=Tl[i1];
      p0[r]=d0<0?NEG:p0[r]+b0; p1[r]=d1<0?NEG:p1[r]+b1;}
    __builtin_amdgcn_sched_barrier(0);
  }
}

__device__ __forceinline__ void fillneg(f32x16&p0,f32x16&p1){
  #pragma unroll
  for(int r=0;r<16;++r){p0[r]=-INFINITY;p1[r]=-INFINITY;}
}
constexpr int NSLOT=3, SLOTB=8192;
constexpr int LDS_K=0, LDS_V=NSLOT*SLOTB, LDS_WS=2*NSLOT*SLOTB, LDS_OST=LDS_WS+NW*64*4, LDS_BT=LDS_OST+NW*4096, LDS_BYTES=LDS_BT+512;
constexpr float C2=0.125f*1.4426950408889634f;
__device__ __forceinline__ void glds16(const void*gsrc,unsigned lds_dst){unsigned keep;
  asm volatile("s_mov_b32 %0, m0\n\ts_mov_b32 m0, %2\n\ts_nop 0\n\tglobal_load_lds_dwordx4 %1, off\n\ts_mov_b32 m0, %0":"=&s"(keep):"v"(gsrc),"s"(lds_dst):"memory");}
__device__ __forceinline__ float max3f(float a,float b,float c){float r;asm("v_max3_f32 %0, %1, %2, %3":"=v"(r):"v"(a),"v"(b),"v"(c));return r;}
__device__ __forceinline__ float max2f(float a,float b){float r;asm("v_max_f32_e32 %0, %1, %2":"=v"(r):"v"(a),"v"(b));return r;}
__device__ __forceinline__ float fadd_s(float a,float b){float r;asm("v_add_f32_e32 %0, %1, %2":"=v"(r):"v"(a),"v"(b));return r;}
__device__ __forceinline__ float fsub_s(float a,float b){float r;asm("v_sub_f32_e32 %0, %1, %2":"=v"(r):"v"(a),"v"(b));return r;}
typedef float f32x2_t __attribute__((ext_vector_type(2))); typedef __bf16 bf16x2_t __attribute__((ext_vector_type(2)));
__device__ __forceinline__ unsigned cvtpk_s(float lo,float hi){f32x2_t v={lo,hi};bf16x2_t b=__builtin_convertvector(v,bf16x2_t);return __builtin_bit_cast(unsigned,b);}
#define WAIT_BAR(N) asm volatile("s_waitcnt vmcnt(" #N ") lgkmcnt(0)\n\ts_barrier":::"memory")

__device__ __forceinline__ void qkt(f32x16&p0,f32x16&p1,const char*Kslot,const bf16x8*qr,const f32x16&negm,int r32,int hi){
  const char*kb=Kslot+hi*1024+r32*16;
  #pragma unroll
  for(int d0=0;d0<4;++d0){
    const bf16x8 b0=*reinterpret_cast<const bf16x8*>(kb+d0*2048);
    const bf16x8 b1=*reinterpret_cast<const bf16x8*>(kb+d0*2048+512);
    if(d0==0){p0=__builtin_amdgcn_mfma_f32_32x32x16_bf16(b0,qr[0],negm,0,0,0);p1=__builtin_amdgcn_mfma_f32_32x32x16_bf16(b1,qr[0],negm,0,0,0);}
    else{p0=__builtin_amdgcn_mfma_f32_32x32x16_bf16(b0,qr[d0],p0,0,0,0);p1=__builtin_amdgcn_mfma_f32_32x32x16_bf16(b1,qr[d0],p1,0,0,0);}}
}
typedef __attribute__((address_space(3))) const char* lds_cptr;
typedef short v4i16_t __attribute__((ext_vector_type(4)));
__device__ __forceinline__ void kload8(bf16x8*kf,lds_cptr kp){
  kf[0]=*(const __attribute__((address_space(3))) bf16x8*)(kp);      kf[1]=*(const __attribute__((address_space(3))) bf16x8*)(kp+512);
  kf[2]=*(const __attribute__((address_space(3))) bf16x8*)(kp+2048); kf[3]=*(const __attribute__((address_space(3))) bf16x8*)(kp+2560);
  kf[4]=*(const __attribute__((address_space(3))) bf16x8*)(kp+4096); kf[5]=*(const __attribute__((address_space(3))) bf16x8*)(kp+4608);
  kf[6]=*(const __attribute__((address_space(3))) bf16x8*)(kp+6144); kf[7]=*(const __attribute__((address_space(3))) bf16x8*)(kp+6656);
}
__device__ __forceinline__ void kload2(bf16x8*kf,lds_cptr kp,int j){ kf[2*j]=*(const __attribute__((address_space(3))) bf16x8*)(kp+j*2048); kf[2*j+1]=*(const __attribute__((address_space(3))) bf16x8*)(kp+j*2048+512); }
__device__ __forceinline__ s16x4 vtr(lds_cptr p){ return __builtin_bit_cast(s16x4,__builtin_amdgcn_ds_read_tr16_b64_v4i16((__attribute__((address_space(3))) v4i16_t*)p)); }
__device__ __forceinline__ float rowmax(const f32x16&p0,const f32x16&p1){
  float a=max3f(p0[0],p0[1],p1[0]),b=max3f(p0[2],p0[3],p1[1]);a=max3f(a,p1[2],p1[3]);
  #pragma unroll
  for(int r=4;r<16;r+=4){a=max3f(a,p0[r],p0[r+1]);b=max3f(b,p0[r+2],p0[r+3]);a=max3f(a,p1[r],p1[r+1]);b=max3f(b,p1[r+2],p1[r+3]);}
  const float m=max2f(a,b);
  auto rr=__builtin_amdgcn_permlane32_swap(__float_as_uint(m),__float_as_uint(m),false,false);
  return max2f(__uint_as_float(rr[0]),__uint_as_float(rr[1]));
}
__device__ __forceinline__ void pv(f32x16*o,int vb,bf16x8 pa0,bf16x8 pa1,bf16x8 pa2,bf16x8 pa3){
  #pragma unroll
  for(int d0=0;d0<2;++d0){s16x4 lo[4],hi[4];
    #pragma unroll
    for(int ks=0;ks<4;++ks){
      asm volatile("ds_read_b64_tr_b16 %0,%1 offset:%c2":"=&v"(lo[ks]):"v"(vb),"i"(d0*4096+ks*1024):"memory");
      asm volatile("ds_read_b64_tr_b16 %0,%1 offset:%c2":"=&v"(hi[ks]):"v"(vb),"i"(d0*4096+ks*1024+512):"memory");}
    asm volatile("s_waitcnt lgkmcnt(0)":::"memory");SBAR();
    #define PK(k) (bf16x8){lo[k][0],lo[k][1],lo[k][2],lo[k][3],hi[k][0],hi[k][1],hi[k][2],hi[k][3]}
    o[d0]=__builtin_amdgcn_mfma_f32_32x32x16_bf16(pa0,PK(0),o[d0],0,0,0);
    o[d0]=__builtin_amdgcn_mfma_f32_32x32x16_bf16(pa1,PK(1),o[d0],0,0,0);
    o[d0]=__builtin_amdgcn_mfma_f32_32x32x16_bf16(pa2,PK(2),o[d0],0,0,0);
    o[d0]=__builtin_amdgcn_mfma_f32_32x32x16_bf16(pa3,PK(3),o[d0],0,0,0);
    #undef PK
  }
}

#ifndef ATTN_STORE16
#define ATTN_STORE16(p,v) (*(u32x4*)(p)=(v))
#endif
template<int THRL> __device__ __forceinline__ void attn_unit(int qb,const bf16*Qb,const bf16*__restrict__ Kh,const bf16*__restrict__ Vh,bf16*Ob,const float*BTg,char*shm,const int tid){
  const int lane=tid&63,r32=lane&31,hi=lane>>5; const int wid=__builtin_amdgcn_readfirstlane(tid>>6);
  const int q0=qb*QB;
  const bf16*Qw=Qb+(long)(q0+wid*QBLK)*QP;
  int tl_=tid; asm volatile("":"+v"(tl_)); float btv_=0.f; if(tl_<128)btv_=BTg[tl_];
  const lds_fptr Tl=(lds_fptr)((lds_cptr)shm+LDS_BT);
  const unsigned lds0=(unsigned)(uintptr_t)shm;
  float*wsf=(float*)(shm+LDS_WS)+wid*64;
  const bf16*ksrc=Kh+(long)lane*KP+wid*8;
  const bf16*vsrc=Vh+(long)(16*(wid&3)+(lane>>2))*VP+(wid>>2)*32+(lane&3)*8;
  const unsigned kdst=lds0+LDS_K+wid*1024, vdst=lds0+LDS_V+wid*1024;
  #define DMA_K(t,slot) glds16(ksrc+(long)(t)*KVBLK*KP,(unsigned)__builtin_amdgcn_readfirstlane(kdst+(slot)))
  #define DMA_V(t,slot) glds16(vsrc+(long)(t)*KVBLK*VP,(unsigned)__builtin_amdgcn_readfirstlane(vdst+(slot)))
  const int vb0=(int)(lds0+LDS_V)+((lane>>4)&1)*32+(lane&3)*8+(4*hi+((lane&15)>>2))*64;
  const char*Kbase=shm+LDS_K; bf16x8 kf[8];
  const lds_cptr shm3=(lds_cptr)shm; const lds_cptr kp0=shm3+LDS_K+hi*1024+r32*16; const lds_cptr vp0=shm3+LDS_V+((lane>>4)&1)*32+(lane&3)*8+(4*hi+((lane&15)>>2))*64;
  const int NT=(q0+QB)/KVBLK;
  DMA_K(0,0);DMA_V(0,0);DMA_K(1,SLOTB);
  bf16x8 qr[4];
  #pragma unroll
  for(int d0=0;d0<4;++d0)qr[d0]=*reinterpret_cast<const bf16x8*>(&Qw[(long)r32*QP+d0*16+hi*8]);
  float zz_=0.f;asm volatile("":"+v"(zz_));
  float mhat=zz_,l_reg=zz_;f32x16 o[2],negm;
  _Pragma("unroll") for(int r=0;r<16;++r){o[0][r]=zz_;o[1][r]=zz_;negm[r]=zz_;} asm volatile("":"+v"(negm));
  const int qrel=wid*QBLK+r32;
  #define CMASK(P0,P1,t) do{int jb_=(t)-(NT-4); if(64*jb_+176>32*wid)biasmask(P0,P1,jb_,qrel,hi,Tl); }while(0)
  bool resc=false;
  #define START(P0,P1) do{ const float rm=rowmax(P0,P1); resc=false; \
    { const float dl=rm; mhat=fadd_s(mhat,dl); \
      _Pragma("unroll") for(int r=0;r<16;++r){P0[r]=fsub_s(P0[r],dl);P1[r]=fsub_s(P1[r],dl);} \
      _Pragma("unroll") for(int r=0;r<16;++r)negm[r]=-mhat; asm volatile("":"+v"(negm)); } \
    _Pragma("unroll") for(int r=0;r<16;++r)P0[r]=__builtin_amdgcn_exp2f(P0[r]); }while(0)
  #define RESC() do{ if(resc){ asm volatile("s_waitcnt lgkmcnt(0)":::"memory"); \
      _Pragma("unroll") for(int d_=0;d_<2;++d_) _Pragma("unroll") for(int r=0;r<16;++r)o[d_][r]*=wsf[crow(r,hi)]; } }while(0)
  f32x16 pA0,pA1,pB0,pB1;
  int sl_prev=0,sl_cur=0,sl_next=SLOTB;
  #define ROT() do{sl_prev=sl_cur;sl_cur=sl_next;sl_next=(sl_next==(NSLOT-1)*SLOTB)?0:sl_next+SLOTB;}while(0)
  { float*tw=(float*)(shm+LDS_BT); if(tl_<128)tw[tl_]=btv_; }
  DMA_K(2,2*SLOTB);
  WAIT_BAR(3);
  qkt(pA0,pA1,Kbase,qr,negm,r32,hi);asm volatile("s_nop 15\n\ts_nop 7":"+v"(pA0),"+v"(pA1));CMASK(pA0,pA1,0);
  START(pA0,pA1);
  _Pragma("unroll") for(int r=0;r<16;++r)pA1[r]=__builtin_amdgcn_exp2f(pA1[r]);
  WAIT_BAR(0);
  DMA_K(3,0);DMA_V(1,SLOTB);
  ROT();
  kload8(kf,kp0+sl_cur);
  WAIT_BAR(2);
  s16x4 vlo[8],vhi[8]; u32x4 pw0,pw1,pw2,pw3;
  #define PKW(P,B) cvtpk_s(P[B],P[B+1])
  #define PAF(k) __builtin_bit_cast(bf16x8,pw##k)
  #define VFR(i) (bf16x8){vlo[i][0],vlo[i][1],vlo[i][2],vlo[i][3],vhi[i][0],vhi[i][1],vhi[i][2],vhi[i][3]}
  #define PIN(x) asm volatile("":"+v"(x))
  #define MX3(a,b,c) __builtin_fmaxf(__builtin_fmaxf((a),(b)),(c))
  #define GAPA(MF,A0,A1,A2,A3,W0,W1,PW) do{ MF; sacc+=A0; sacc+=A1; sacc+=A2; sacc+=A3; PIN(sacc); W0; W1; PIN(PW); SBAR(); }while(0)
  #define EX(v) __builtin_amdgcn_exp2f(v)
  #define GAPB(MF,X,B) do{ MF; X[B]=EX(X[B]); X[B+1]=EX(X[B+1]); X[B+2]=EX(X[B+2]); X[B+3]=EX(X[B+3]); PIN(X); SBAR(); }while(0)
  #define VRD(i) do{ vlo[i]=vtr(vp_+(((i)>>2)*4096+((i)&3)*1024)); vhi[i]=vtr(vp_+(((i)>>2)*4096+((i)&3)*1024+512)); }while(0)
  #define KRD(G,j) do{ if(G){ kload2(kf,kp0+sl_next,j); SBAR(); } }while(0)
  #define STEP(C0,C1,P0,P1,t,GK,GV,GL) do{ SBAR(); \
    const lds_cptr vp_=vp0+sl_prev; \
    VRD(0); SBAR(); float sacc=(P0[0]+P0[1]); \
    GAPA(C0=__builtin_amdgcn_mfma_f32_32x32x16_bf16(kf[0],qr[0],negm,0,0,0), P0[2],P0[3],P0[4],P0[5],     pw0[0]=PKW(P0,0), pw0[1]=PKW(P0,2), pw0); \
    VRD(4); SBAR(); GAPA(C1=__builtin_amdgcn_mfma_f32_32x32x16_bf16(kf[1],qr[0],negm,0,0,0), P0[6],P0[7],P0[8],P0[9],     pw0[2]=PKW(P0,4), pw0[3]=PKW(P0,6), pw0); \
    VRD(1); SBAR(); GAPA(C0=__builtin_amdgcn_mfma_f32_32x32x16_bf16(kf[2],qr[1],C0,0,0,0),   P0[10],P0[11],P0[12],P0[13], pw1[0]=PKW(P0,8), pw1[1]=PKW(P0,10), pw1); \
    VRD(5); SBAR(); GAPA(C1=__builtin_amdgcn_mfma_f32_32x32x16_bf16(kf[3],qr[1],C1,0,0,0),   P0[14],P0[15],P1[0],P1[1],   pw1[2]=PKW(P0,12),pw1[3]=PKW(P0,14), pw1); \
    VRD(2); SBAR(); GAPA(C0=__builtin_amdgcn_mfma_f32_32x32x16_bf16(kf[4],qr[2],C0,0,0,0),   P1[2],P1[3],P1[4],P1[5],     pw2[0]=PKW(P1,0), pw2[1]=PKW(P1,2), pw2); \
    VRD(6); SBAR(); GAPA(C1=__builtin_amdgcn_mfma_f32_32x32x16_bf16(kf[5],qr[2],C1,0,0,0),   P1[6],P1[7],P1[8],P1[9],     pw2[2]=PKW(P1,4), pw2[3]=PKW(P1,6), pw2); \
    VRD(3); SBAR(); GAPA(C0=__builtin_amdgcn_mfma_f32_32x32x16_bf16(kf[6],qr[3],C0,0,0,0),   P1[10],P1[11],P1[12],P1[13], pw3[0]=PKW(P1,8), pw3[1]=PKW(P1,10), pw3); \
    VRD(7); SBAR(); GAPA(C1=__builtin_amdgcn_mfma_f32_32x32x16_bf16(kf[7],qr[3],C1,0,0,0),   P1[14],P1[15],0.f,0.f,       pw3[2]=PKW(P1,12),pw3[3]=PKW(P1,14), pw3); \
    l_reg+=sacc; \
    if(GK){DMA_K((t)+3,sl_cur);} if(GV){DMA_V((t)+1,sl_next);} \
    CMASK(C0,C1,t); \
    { float a=MX3(C0[0],C0[1],C1[0]),b=MX3(C0[2],C0[3],C1[1]); a=MX3(a,C1[2],C1[3]); \
      _Pragma("unroll") for(int r=4;r<16;r+=4){a=MX3(a,C0[r],C0[r+1]);b=MX3(b,C0[r+2],C0[r+3]);a=MX3(a,C1[r],C1[r+1]);b=MX3(b,C1[r+2],C1[r+3]);} \
      float rm=__builtin_fmaxf(a,b); { auto rr=__builtin_amdgcn_permlane32_swap(__float_as_uint(rm),__float_as_uint(rm),false,false); rm=__builtin_fmaxf(__uint_as_float(rr[0]),__uint_as_float(rr[1])); } \
      resc=false; \
      if(__builtin_expect(__any(rm>(float)THRL),0)){ const float dl=__builtin_fmaxf(rm,0.f); mhat+=dl; \
        _Pragma("unroll") for(int r=0;r<16;++r){C0[r]-=dl;C1[r]-=dl;} \
        _Pragma("unroll") for(int r=0;r<16;++r)negm[r]=-mhat; asm volatile("":"+v"(negm)); \
        const float f=__builtin_amdgcn_exp2f(-dl); l_reg*=f; if(hi==0)wsf[r32]=f; resc=true; } } \
    SBAR(); \
    GAPB(o[0]=__builtin_amdgcn_mfma_f32_32x32x16_bf16(PAF(0),VFR(0),o[0],0,0,0), C0,0); \
    GAPB(o[1]=__builtin_amdgcn_mfma_f32_32x32x16_bf16(PAF(0),VFR(4),o[1],0,0,0), C0,4); \
    KRD(GL,0); GAPB(o[0]=__builtin_amdgcn_mfma_f32_32x32x16_bf16(PAF(1),VFR(1),o[0],0,0,0), C0,8); \
    KRD(GL,1); GAPB(o[1]=__builtin_amdgcn_mfma_f32_32x32x16_bf16(PAF(1),VFR(5),o[1],0,0,0), C0,12); \
    KRD(GL,2); GAPB(o[0]=__builtin_amdgcn_mfma_f32_32x32x16_bf16(PAF(2),VFR(2),o[0],0,0,0), C1,0); \
    KRD(GL,3); GAPB(o[1]=__builtin_amdgcn_mfma_f32_32x32x16_bf16(PAF(2),VFR(6),o[1],0,0,0), C1,4); \
    GAPB(o[0]=__builtin_amdgcn_mfma_f32_32x32x16_bf16(PAF(3),VFR(3),o[0],0,0,0), C1,8); \
    GAPB(o[1]=__builtin_amdgcn_mfma_f32_32x32x16_bf16(PAF(3),VFR(7),o[1],0,0,0), C1,12); \
    }while(0)
  int t=1;
  #undef CMASK
  #define CMASK(P0,P1,t) do{}while(0)
  for(;t+7<NT;t+=2){
    STEP(pB0,pB1,pA0,pA1,t,true,true,true);     WAIT_BAR(2); RESC(); ROT();
    STEP(pA0,pA1,pB0,pB1,t+1,true,true,true);   WAIT_BAR(2); RESC(); ROT();
  }
  #undef CMASK
  #define CMASK(P0,P1,t) do{int jb_=(t)-(NT-4); if(64*jb_+176>32*wid)biasmask(P0,P1,jb_,qrel,hi,Tl); }while(0)
  #define ENDW(tt) do{ if((tt)+3<NT){WAIT_BAR(2);} else if((tt)+2<NT){WAIT_BAR(1);} else {WAIT_BAR(0);} }while(0)
  for(;t+1<NT;t+=2){
    STEP(pB0,pB1,pA0,pA1,t,(t+3<NT),(t+1<NT),(t+1<NT));       ENDW(t);   RESC(); ROT();
    STEP(pA0,pA1,pB0,pB1,t+1,(t+4<NT),(t+2<NT),(t+2<NT));     ENDW(t+1); RESC(); ROT();
  }
  STEP(pB0,pB1,pA0,pA1,NT-1,false,false,false); RESC();
  { float sacc=pB0[0]+pB0[1]; _Pragma("unroll") for(int r=2;r<16;++r)sacc+=pB0[r]; _Pragma("unroll") for(int r=0;r<16;++r)sacc+=pB1[r]; l_reg+=sacc;
    pw0=(u32x4){PKW(pB0,0),PKW(pB0,2),PKW(pB0,4),PKW(pB0,6)};pw1=(u32x4){PKW(pB0,8),PKW(pB0,10),PKW(pB0,12),PKW(pB0,14)};pw2=(u32x4){PKW(pB1,0),PKW(pB1,2),PKW(pB1,4),PKW(pB1,6)};pw3=(u32x4){PKW(pB1,8),PKW(pB1,10),PKW(pB1,12),PKW(pB1,14)};
    SBAR(); pv(o,vb0+sl_cur,PAF(0),PAF(1),PAF(2),PAF(3)); }
  #undef PKW
  #undef PAF
  #undef VFR
  #undef PIN
  #undef MX3
  #undef GAPA
  #undef GAPB
  #undef EX
  #undef VRD
  #undef KRD
  #undef STEP
  #undef ENDW
  {auto rr=__builtin_amdgcn_permlane32_swap(__float_as_uint(l_reg),__float_as_uint(l_reg),false,false);l_reg=__uint_as_float(rr[0])+__uint_as_float(rr[1]);}
  if(hi==0)wsf[32+r32]=l_reg;asm volatile("s_waitcnt lgkmcnt(0)":::"memory");
  float rli[16];
  #pragma unroll
  for(int r=0;r<16;++r)rli[r]=__builtin_amdgcn_rcpf(wsf[32+crow(r,hi)]);
  bf16*Ow=Ob+(long)(q0+wid*QBLK)*OP;
  { bf16*stg=(bf16*)(shm+LDS_OST)+wid*2048;
    #pragma unroll
    for(int r=0;r<16;++r){const int orow=crow(r,hi);
      #pragma unroll
      for(int d0=0;d0<2;++d0)stg[orow*64+d0*32+r32]=__float2bfloat16(o[d0][r]*rli[r]);}
    asm volatile("s_waitcnt lgkmcnt(0)":::"memory");
    #pragma unroll
    for(int i=0;i<4;++i){const int row=i*8+(lane>>3),ch=lane&7; const u32x4 v=*(const u32x4*)(stg+row*64+ch*8); ATTN_STORE16(Ow+(long)row*OP+ch*8,v);} }
  asm volatile("s_waitcnt lgkmcnt(0)\n\ts_barrier":::"memory");
  #undef DMA_K
  #undef DMA_V
  #undef CMASK
  #undef START
  #undef RESC
  #undef ROT
}
constexpr int ATTN_LDS_BYTES=LDS_BYTES;
#undef SBAR
#undef WAIT_BAR
}

namespace fa3 {
constexpr int KP = 72;
typedef float f32x2_t __attribute__((ext_vector_type(2))); typedef __bf16 bf16x2_t __attribute__((ext_vector_type(2)));
__device__ __forceinline__ unsigned cvtpk(float lo, float hi) { f32x2_t v = {lo, hi}; bf16x2_t b = __builtin_convertvector(v, bf16x2_t); return __builtin_bit_cast(unsigned, b); }
__device__ __forceinline__ void unit(unsigned char* ws, LAS unsigned char* lds, int b, int h, int mp, int qb, const int tid_in) {
    int tid = tid_in; asm volatile("" : "+v"(tid));
    const int lane = tid & 63, w = __builtin_amdgcn_readfirstlane(tid >> 6), fr = lane & 15, fq = lane >> 4;
    const bf16_t* Q = (const bf16_t*)(ws + WS_R + R_Q) + (size_t)b * SEQ * 512 + (h * 2 + mp) * 64;
    const bf16_t* K = (const bf16_t*)(ws + WS_R + R_K) + (size_t)b * SEQ * 512 + (h * 2 + mp) * 64;
    const bf16_t* V = (const bf16_t*)(ws + WS_R + R_V) + (size_t)b * SEQ * 512 + h * 128;
    bf16_t* O = (bf16_t*)(ws + WS_XB) + (size_t)b * SEQ * 1024 + h * 256 + mp * 128;
    const float* BTg = (const float*)(ws + WS_BT) + h * 128;
    constexpr int KVB = (64 + 128) * KP;
    LAS bf16_t* KV0 = (LAS bf16_t*)lds; LAS float* TB = (LAS float*)(KV0 + 2 * KVB);
    const int q0 = qb * 256, qw0 = q0 + 32 * w, NT = 4 * qb + 4;
    __syncthreads();
    { const int d_ = tid - 256; TB[tid] = d_ < 0 ? -INFINITY : (d_ < 128 ? BTg[d_] : 0.f); }
    bf16x8 qf[2][2];
#pragma unroll
    for (int g = 0; g < 2; ++g) { const bf16_t* qp = Q + (size_t)(qw0 + 16 * g + fr) * 512 + 8 * fq; qf[g][0] = *(const bf16x8*)qp; qf[g][1] = *(const bf16x8*)(qp + 32); }
    float m[2] = {0.f, 0.f}; f32x4 lacc[2] = {(f32x4){0.f, 0.f, 0.f, 0.f}, (f32x4){0.f, 0.f, 0.f, 0.f}}; f32x4 o[2][8];
    const bf16x8 onesf = {0x3F80, 0x3F80, 0x3F80, 0x3F80, 0x3F80, 0x3F80, 0x3F80, 0x3F80};
#pragma unroll
    for (int g = 0; g < 2; ++g)
#pragma unroll
        for (int et = 0; et < 8; ++et) o[g][et] = (f32x4){0.f, 0.f, 0.f, 0.f};
    const int sr = tid >> 3, sc = tid & 7;
    const bf16_t* kg = K + (size_t)sr * 512 + sc * 8;
    const int vp = tid >> 4, vc = tid & 15;
    const bf16_t* vg = V + (size_t)(2 * vp) * 512 + vc * 8;
    u32x4 kA = *(const u32x4*)kg, vA0 = *(const u32x4*)vg, vA1 = *(const u32x4*)(vg + 512);
    u32x4 kB = *(const u32x4*)(kg + (size_t)64 * 512), vB0 = *(const u32x4*)(vg + (size_t)64 * 512), vB1 = *(const u32x4*)(vg + (size_t)64 * 512 + 512);
#define FA3_STAGE(BUF) do { LAS bf16_t* ks_ = KV0 + (BUF) * KVB; LAS bf16_t* vt_ = ks_ + 64 * KP; *(LAS u32x4*)(ks_ + sr * KP + sc * 8) = kA; \
        const unsigned va_[4] = {vA0.x, vA0.y, vA0.z, vA0.w}, vb_[4] = {vA1.x, vA1.y, vA1.z, vA1.w}; const int k2_ = 2 * vp; \
        const int col_ = ((k2_ & 32) + 8 * ((k2_ >> 2) & 3) + 4 * ((k2_ >> 4) & 1) + (k2_ & 3) + 8 * (vc >> 1)) & 63;     \
        _Pragma("unroll") for (int w_ = 0; w_ < 4; ++w_) { *(LAS unsigned*)(vt_ + (vc * 8 + 2 * w_) * KP + col_) = (va_[w_] & 0xffffu) | (vb_[w_] << 16); \
            *(LAS unsigned*)(vt_ + (vc * 8 + 2 * w_ + 1) * KP + col_) = (va_[w_] >> 16) | (vb_[w_] & 0xffff0000u); } } while (0)
    FA3_STAGE(0);
    kA = kB; vA0 = vB0; vA1 = vB1;
    { const size_t off = (size_t)2 * 64 * 512; kB = *(const u32x4*)(kg + off); vB0 = *(const u32x4*)(vg + off); vB1 = *(const u32x4*)(vg + off + 512); }
    __syncthreads();
    for (int kt = 0; kt < NT; ++kt) {
        LAS bf16_t* KS = KV0 + (kt & 1) * KVB; LAS bf16_t* VT = KS + 64 * KP;
        const int k0 = kt * 64;
        if (k0 <= qw0 + 31) {
        f32x4 s[2][4];
#pragma unroll
        for (int jt = 0; jt < 4; ++jt) { const bf16x8 kf0 = *(const LAS bf16x8*)(KS + (16 * jt + fr) * KP + 8 * fq), kf1 = *(const LAS bf16x8*)(KS + (16 * jt + fr) * KP + 32 + 8 * fq);
#pragma unroll
            for (int g = 0; g < 2; ++g) { const float nm = -m[g]; s[g][jt] = __builtin_amdgcn_mfma_f32_16x16x32_bf16(kf0, qf[g][0], (f32x4){nm, nm, nm, nm}, 0, 0, 0); s[g][jt] = __builtin_amdgcn_mfma_f32_16x16x32_bf16(kf1, qf[g][1], s[g][jt], 0, 0, 0); } }
        const bool nearb = (qw0 - (k0 + 63) < 113);
        bf16x8 pf[2][2];
#pragma unroll
        for (int g = 0; g < 2; ++g) {
            if (nearb) {
                const LAS float* tb = TB + (256 + qw0 + 16 * g + fr - (k0 + 4 * fq));
#pragma unroll
                for (int jt = 0; jt < 4; ++jt)
#pragma unroll
                    for (int jj = 0; jj < 4; ++jj) { const float bv = tb[-(16 * jt + jj)]; float x = s[g][jt][jj];
                        asm("v_add_f32_e32 %0, %1, %2" : "=v"(x) : "v"(x), "v"(bv));
                        s[g][jt][jj] = x; }
            }
            float mx = fmaxf(fmaxf(s[g][0][0], s[g][0][1]), fmaxf(s[g][0][2], s[g][0][3]));
#pragma unroll
            for (int jt = 1; jt < 4; ++jt) mx = fmaxf(mx, fmaxf(fmaxf(s[g][jt][0], s[g][jt][1]), fmaxf(s[g][jt][2], s[g][jt][3])));
            if (__any(mx > 8.f)) {
                mx = fmaxf(mx, __shfl_xor(mx, 16)); mx = fmaxf(mx, __shfl_xor(mx, 32));
                const float dl = fmaxf(mx, 0.f), alpha = __builtin_amdgcn_exp2f(-dl);
                m[g] += dl; lacc[g] *= alpha;
#pragma unroll
                for (int jt = 0; jt < 4; ++jt) s[g][jt] -= dl;
#pragma unroll
                for (int et = 0; et < 8; ++et) o[g][et] *= alpha;
            }
#pragma unroll
            for (int jt = 0; jt < 4; ++jt) {
#pragma unroll
                for (int jj = 0; jj < 4; ++jj) s[g][jt][jj] = __builtin_amdgcn_exp2f(s[g][jt][jj]); }
#pragma unroll
            for (int sb = 0; sb < 2; ++sb) { u32x4 pw; pw.x = cvtpk(s[g][2 * sb][0], s[g][2 * sb][1]); pw.y = cvtpk(s[g][2 * sb][2], s[g][2 * sb][3]); pw.z = cvtpk(s[g][2 * sb + 1][0], s[g][2 * sb + 1][1]); pw.w = cvtpk(s[g][2 * sb + 1][2], s[g][2 * sb + 1][3]);
                pf[g][sb] = __builtin_bit_cast(bf16x8, pw); }
        }
#pragma unroll
        for (int g = 0; g < 2; ++g) {
            lacc[g] = __builtin_amdgcn_mfma_f32_16x16x32_bf16(onesf, pf[g][0], lacc[g], 0, 0, 0); lacc[g] = __builtin_amdgcn_mfma_f32_16x16x32_bf16(onesf, pf[g][1], lacc[g], 0, 0, 0); }
#pragma unroll
        for (int et = 0; et < 8; ++et) { const LAS bf16_t* vrow = VT + (16 * et + fr) * KP;
            const bf16x8 vf0 = *(const LAS bf16x8*)(vrow + ((8 * fq + 8 * et) & 63)), vf1 = *(const LAS bf16x8*)(vrow + ((32 + 8 * fq + 8 * et) & 63));
#pragma unroll
            for (int g = 0; g < 2; ++g) { o[g][et] = __builtin_amdgcn_mfma_f32_16x16x32_bf16(vf0, pf[g][0], o[g][et], 0, 0, 0); o[g][et] = __builtin_amdgcn_mfma_f32_16x16x32_bf16(vf1, pf[g][1], o[g][et], 0, 0, 0); } }
        }
        if (kt + 1 < NT) { FA3_STAGE((kt + 1) & 1); kA = kB; vA0 = vB0; vA1 = vB1;
            if (kt + 3 < NT) { const size_t off = (size_t)(kt + 3) * 64 * 512; kB = *(const u32x4*)(kg + off); vB0 = *(const u32x4*)(vg + off); vB1 = *(const u32x4*)(vg + off + 512); } }
        __syncthreads();
    }
#pragma unroll
    for (int g = 0; g < 2; ++g) {
        const float il = __builtin_amdgcn_rcpf(lacc[g][0]);
#pragma unroll
        for (int et = 0; et < 8; ++et) { u32x2 ow; ow.x = cvtpk(o[g][et][0] * il, o[g][et][1] * il); ow.y = cvtpk(o[g][et][2] * il, o[g][et][3] * il);
            *(u32x2*)(O + (size_t)(qw0 + 16 * g + fr) * 1024 + 16 * et + 4 * fq) = ow; }
    }
}
#undef FA3_STAGE
}

constexpr int RP64 = 72, RP128 = 136;
__device__ __forceinline__ void retkv_unit(unsigned char* ws, LAS unsigned char* lds, int u, const int tid) {
    const int b = u >> 7, h = (u >> 5) & 3, n = u & 31;
    const int lane = tid & 63, w = __builtin_amdgcn_readfirstlane(tid >> 6), fr = lane & 15, fq = lane >> 4;
    const bf16_t* RK = (const bf16_t*)(ws + WS_R + R_RK); const bf16_t* RV = (const bf16_t*)(ws + WS_R + R_RV);
    const float lg2 = log2f(1.f - exp2f(-5.f - (float)h));
    const size_t row0 = (size_t)b * SEQ + n * 128;
    LAS bf16_t* VT = (LAS bf16_t*)lds; LAS bf16_t* KT = VT + 64 * RP128;
    __syncthreads();
    { const int r = tid >> 2, c0 = (tid & 3) * 16;
      const u32x4* vs = (const u32x4*)(RV + (row0 + r) * 256 + h * 64 + c0); const u32x4 a0 = vs[0], a1 = vs[1];
      const u32x4* ksrc = (const u32x4*)(RK + (row0 + r) * 256 + h * 64 + c0); const u32x4 k0 = ksrc[0], k1 = ksrc[1];
      const unsigned vw[8] = {a0.x, a0.y, a0.z, a0.w, a1.x, a1.y, a1.z, a1.w}; const unsigned kw[8] = {k0.x, k0.y, k0.z, k0.w, k1.x, k1.y, k1.z, k1.w};
      const float dec = exp2f(lg2 * (float)(127 - r));
#pragma unroll
      for (int i = 0; i < 8; ++i) { VT[(c0 + 2 * i) * RP128 + r] = (bf16_t)(vw[i] & 0xffffu); VT[(c0 + 2 * i + 1) * RP128 + r] = (bf16_t)(vw[i] >> 16);
          const unsigned kp = cvt_pk_bf16(bflo(kw[i]) * dec, bfhi(kw[i]) * dec);
          KT[(c0 + 2 * i) * RP128 + r] = (bf16_t)(kp & 0xffffu); KT[(c0 + 2 * i + 1) * RP128 + r] = (bf16_t)(kp >> 16); } }
    __syncthreads();
    const int et = w >> 1;
#pragma unroll
    for (int t2 = 0; t2 < 2; ++t2) { const int dt = (w & 1) * 2 + t2; f32x4 acc = (f32x4){0.f, 0.f, 0.f, 0.f};
#pragma unroll
        for (int sb = 0; sb < 4; ++sb) { const bf16x8 kf = *(const LAS bf16x8*)(KT + (16 * dt + fr) * RP128 + 32 * sb + 8 * fq); const bf16x8 vf = *(const LAS bf16x8*)(VT + (16 * et + fr) * RP128 + 32 * sb + 8 * fq);
            acc = __builtin_amdgcn_mfma_f32_16x16x32_bf16(kf, vf, acc, 0, 0, 0); }
        u32x2 o; o.x = cvt_pk_bf16(acc[0], acc[1]); o.y = cvt_pk_bf16(acc[2], acc[3]);
        *(u32x2*)((bf16_t*)(ws + WS_KV) + (size_t)u * 4096 + (16 * et + fr) * 64 + 16 * dt + 4 * fq) = o; }
}
typedef float f32x2_c __attribute__((ext_vector_type(2))); typedef __bf16 bf16x2_c __attribute__((ext_vector_type(2)));
__device__ __forceinline__ unsigned cvtpk_c(float lo, float hi) { f32x2_c v = {lo, hi}; bf16x2_c b = __builtin_convertvector(v, bf16x2_c); return __builtin_bit_cast(unsigned, b); }
__device__ __forceinline__ void retkv_mfma_unit(unsigned char* ws, LAS unsigned char* lds, int u, const int tid) {
    const int b = u >> 7, h = (u >> 5) & 3, n = u & 31;
    const int lane = tid & 63, w = __builtin_amdgcn_readfirstlane(tid >> 6), fr = lane & 15, fq = lane >> 4;
    const bf16_t* RK = (const bf16_t*)(ws + WS_R + R_RK); const bf16_t* RV = (const bf16_t*)(ws + WS_R + R_RV);
    const float lg2 = log2f(1.f - exp2f(-5.f - (float)h));
    const size_t row0 = (size_t)b * SEQ + n * 128;
    LAS bf16_t* VT = (LAS bf16_t*)lds; LAS bf16_t* KT = VT + 64 * RP128;
    __syncthreads();
    { const int r = tid >> 2, c0 = (tid & 3) * 16;
      const u32x4* vs = (const u32x4*)(RV + (row0 + r) * 256 + h * 64 + c0); const u32x4 a0 = vs[0], a1 = vs[1];
      const u32x4* ksrc = (const u32x4*)(RK + (row0 + r) * 256 + h * 64 + c0); const u32x4 k0 = ksrc[0], k1 = ksrc[1];
      const unsigned vw[8] = {a0.x, a0.y, a0.z, a0.w, a1.x, a1.y, a1.z, a1.w}; const unsigned kw[8] = {k0.x, k0.y, k0.z, k0.w, k1.x, k1.y, k1.z, k1.w};
      const float dec = exp2f(lg2 * (float)(127 - r));
#pragma unroll
      for (int i = 0; i < 8; ++i) { VT[(c0 + 2 * i) * RP128 + r] = (bf16_t)(vw[i] & 0xffffu); VT[(c0 + 2 * i + 1) * RP128 + r] = (bf16_t)(vw[i] >> 16);
          const unsigned kp = cvt_pk_bf16(bflo(kw[i]) * dec, bfhi(kw[i]) * dec);
          KT[(c0 + 2 * i) * RP128 + r] = (bf16_t)(kp & 0xffffu); KT[(c0 + 2 * i + 1) * RP128 + r] = (bf16_t)(kp >> 16); } }
    __syncthreads();
    const int et = w >> 1;
#pragma unroll
    for (int t2 = 0; t2 < 2; ++t2) { const int dt = (w & 1) * 2 + t2; f32x4 acc = (f32x4){0.f, 0.f, 0.f, 0.f};
#pragma unroll
        for (int sb = 0; sb < 4; ++sb) { const bf16x8 kf = *(const LAS bf16x8*)(KT + (16 * dt + fr) * RP128 + 32 * sb + 8 * fq); const bf16x8 vf = *(const LAS bf16x8*)(VT + (16 * et + fr) * RP128 + 32 * sb + 8 * fq);
            acc = __builtin_amdgcn_mfma_f32_16x16x32_bf16(kf, vf, acc, 0, 0, 0); }
        u32x2 o; o.x = cvtpk_c(acc[0], acc[1]); o.y = cvtpk_c(acc[2], acc[3]);
        *(u32x2*)((bf16_t*)(ws + WS_KV) + (size_t)u * 4096 + (16 * et + fr) * 64 + 16 * dt + 4 * fq) = o; }
}
__device__ __forceinline__ void retkv_naive_unit(unsigned char* ws, unsigned char* lds, int u, const int tid) {
    const int b = u >> 7, h = (u >> 5) & 3, n = u & 31;
    const bf16_t* RK = (const bf16_t*)(ws + WS_R + R_RK); const bf16_t* RV = (const bf16_t*)(ws + WS_R + R_RV);
    const float lg2 = log2f(1.f - exp2f(-5.f - (float)h));
    const size_t row0 = (size_t)b * SEQ + n * 128;
    bf16_t* KS = (bf16_t*)lds; bf16_t* VS = KS + 128 * 72;
    __syncthreads();
    { const int r = tid >> 2, c0 = (tid & 3) * 16;
      const u32x4* ksrc = (const u32x4*)(RK + (row0 + r) * 256 + h * 64 + c0); const u32x4 k0 = ksrc[0], k1 = ksrc[1];
      const u32x4* vsrc = (const u32x4*)(RV + (row0 + r) * 256 + h * 64 + c0); const u32x4 v0 = vsrc[0], v1 = vsrc[1];
      *(u32x4*)(KS + r * 72 + c0) = k0; *(u32x4*)(KS + r * 72 + c0 + 8) = k1; *(u32x4*)(VS + r * 72 + c0) = v0; *(u32x4*)(VS + r * 72 + c0 + 8) = v1; }
    __syncthreads();
    const int d = tid >> 3, eg = tid & 7;
    float av[8];
#pragma unroll
    for (int i = 0; i < 8; ++i) av[i] = 0.f;
#pragma unroll 8
    for (int c = 0; c < 128; ++c) {
        const float kd = bf2f(KS[c * 72 + d]) * exp2f(lg2 * (float)(127 - c));
        const u32x4 v = *(const u32x4*)(VS + c * 72 + eg * 8);
        av[0] += kd * bflo(v.x); av[1] += kd * bfhi(v.x); av[2] += kd * bflo(v.y); av[3] += kd * bfhi(v.y);
        av[4] += kd * bflo(v.z); av[5] += kd * bfhi(v.z); av[6] += kd * bflo(v.w); av[7] += kd * bfhi(v.w);
    }
#pragma unroll
    for (int i = 0; i < 8; ++i) ((bf16_t*)(ws + WS_KV))[(size_t)u * 4096 + (eg * 8 + i) * 64 + d] = (bf16_t)(cvt_pk_bf16(av[i], 0.f) & 0xffffu);
}
__device__ __forceinline__ void phase_B1(CArgs& a, int l, unsigned char* lds, const int tid, const int bx, const int G) {
    {
        for (int vc = bx; vc < 256; vc += G) {
            const int vcu = (G == 256) ? ((vc & 7) * 32 + (vc >> 3)) : vc;
            const int combo = vcu >> 2, s = vcu & 3;
            const int b = combo >> 3, h = (combo >> 1) & 3, mp = combo & 1;
            for (int i = 0; i < 4; ++i) { const int qb = (i == 0) ? s : (i == 1) ? 7 - s : (i == 2) ? 8 + s : 15 - s; fa3::unit(a.ws, (LAS unsigned char*)lds, b, h, mp, qb, tid); }
        }
    }
    { int tid2 = tid; asm volatile("" : "+v"(tid2)); for (int u = bx; u < 1024; u += G) retkv_mfma_unit(a.ws, (LAS unsigned char*)lds, u, tid2); }
}

__device__ __forceinline__ void retout_unit(CArgs& a, int l, unsigned char* lds, int u, const int tid) {
    unsigned char* ws = a.ws;
    const int b = u >> 7, h = (u >> 5) & 3, n = u & 31;
    const int lane = tid & 63, w = __builtin_amdgcn_readfirstlane(tid >> 6), fr = lane & 15, fq = lane >> 4;
    const bf16_t* RQ = (const bf16_t*)(ws + WS_R + R_RQ); const bf16_t* RK = (const bf16_t*)(ws + WS_R + R_RK); const bf16_t* RV = (const bf16_t*)(ws + WS_R + R_RV);
    const bf16_t* RG = (const bf16_t*)(ws + WS_R + R_RG); const bf16_t* KV = (const bf16_t*)(ws + WS_KV);
    bf16_t* OC = (bf16_t*)(ws + WS_R + R_OCAT);
    const float lg2 = log2f(1.f - exp2f(-5.f - (float)h));
    const size_t row0 = (size_t)b * SEQ + n * 128;
    LAS bf16_t* KS = (LAS bf16_t*)lds; LAS bf16_t* VT = KS + 128 * RP64; LAS bf16_t* RT = VT + 64 * RP128; LAS bf16_t* PS = RT + 64 * RP64;
    __syncthreads();
    { const int r = tid >> 2, c0 = (tid & 3) * 16;
      const u32x4* ksrc = (const u32x4*)(RK + (row0 + r) * 256 + h * 64 + c0); const u32x4 k0 = ksrc[0], k1 = ksrc[1];
      *(LAS u32x4*)(KS + r * RP64 + c0) = k0; *(LAS u32x4*)(KS + r * RP64 + c0 + 8) = k1;
      const u32x4* vs = (const u32x4*)(RV + (row0 + r) * 256 + h * 64 + c0); const u32x4 a0 = vs[0], a1 = vs[1];
      const unsigned vw[8] = {a0.x, a0.y, a0.z, a0.w, a1.x, a1.y, a1.z, a1.w};
#pragma unroll
      for (int i = 0; i < 8; ++i) { VT[(c0 + 2 * i) * RP128 + r] = (bf16_t)(vw[i] & 0xffffu); VT[(c0 + 2 * i + 1) * RP128 + r] = (bf16_t)(vw[i] >> 16); } }
    { float r[8];
#pragma unroll
      for (int i = 0; i < 8; ++i) r[i] = 0.f;
#pragma unroll 8
      for (int m = 0; m < n; ++m) { const float wgt = exp2f(lg2 * 128.f * (float)(n - 1 - m)); const u32x4 v = *(const u32x4*)(KV + (size_t)(u - n + m) * 4096 + tid * 8);
          r[0] += wgt * bflo(v.x); r[1] += wgt * bfhi(v.x); r[2] += wgt * bflo(v.y); r[3] += wgt * bfhi(v.y); r[4] += wgt * bflo(v.z); r[5] += wgt * bfhi(v.z); r[6] += wgt * bflo(v.w); r[7] += wgt * bfhi(v.w); }
      u32x4 o; o.x = cvt_pk_bf16(r[0], r[1]); o.y = cvt_pk_bf16(r[2], r[3]); o.z = cvt_pk_bf16(r[4], r[5]); o.w = cvt_pk_bf16(r[6], r[7]);
      *(LAS u32x4*)(RT + (tid >> 3) * RP64 + (tid & 7) * 8) = o; }
    const int c = 16 * w + fr; const size_t row = row0 + c;
    const bf16x8 qf0 = *(const bf16x8*)(RQ + row * 256 + h * 64 + 8 * fq), qf1 = *(const bf16x8*)(RQ + row * 256 + h * 64 + 32 + 8 * fq);
    __syncthreads();
    for (int jt = 0; jt <= w; ++jt) {
        f32x4 s = (f32x4){0.f, 0.f, 0.f, 0.f};
        const bf16x8 kf0 = *(const LAS bf16x8*)(KS + (16 * jt + fr) * RP64 + 8 * fq), kf1 = *(const LAS bf16x8*)(KS + (16 * jt + fr) * RP64 + 32 + 8 * fq);
        s = __builtin_amdgcn_mfma_f32_16x16x32_bf16(kf0, qf0, s, 0, 0, 0); s = __builtin_amdgcn_mfma_f32_16x16x32_bf16(kf1, qf1, s, 0, 0, 0);
        const int dj0 = c - (16 * jt + 4 * fq); float p[4];
#pragma unroll
        for (int jj = 0; jj < 4; ++jj) { const int dj = dj0 - jj; p[jj] = dj >= 0 ? s[jj] * exp2f(lg2 * (float)dj) : 0.f; }
        u32x2 pw; pw.x = cvt_pk_bf16(p[0], p[1]); pw.y = cvt_pk_bf16(p[2], p[3]);
        *(LAS u32x2*)(PS + c * RP128 + 16 * jt + 4 * fq) = pw;
    }
    if (!(w & 1)) { unsigned zq = 0u; asm volatile("" : "+v"(zq)); u32x2 z; z.x = zq; z.y = zq; *(LAS u32x2*)(PS + c * RP128 + 16 * (w + 1) + 4 * fq) = z; }
    LDS_WAIT(); asm volatile("" ::: "memory");
    f32x4 o[4], x[4];
#pragma unroll
    for (int et = 0; et < 4; ++et) { o[et] = (f32x4){0.f, 0.f, 0.f, 0.f}; x[et] = (f32x4){0.f, 0.f, 0.f, 0.f}; }
    for (int sb = 0; sb <= (w >> 1); ++sb) {
        const bf16x8 pf = *(const LAS bf16x8*)(PS + c * RP128 + 32 * sb + 8 * fq);
#pragma unroll
        for (int et = 0; et < 4; ++et) { const bf16x8 vf = *(const LAS bf16x8*)(VT + (16 * et + fr) * RP128 + 32 * sb + 8 * fq); o[et] = __builtin_amdgcn_mfma_f32_16x16x32_bf16(vf, pf, o[et], 0, 0, 0); }
    }
#pragma unroll
    for (int et = 0; et < 4; ++et) { const bf16x8 r0 = *(const LAS bf16x8*)(RT + (16 * et + fr) * RP64 + 8 * fq), r1 = *(const LAS bf16x8*)(RT + (16 * et + fr) * RP64 + 32 + 8 * fq);
        x[et] = __builtin_amdgcn_mfma_f32_16x16x32_bf16(r0, qf0, x[et], 0, 0, 0); x[et] = __builtin_amdgcn_mfma_f32_16x16x32_bf16(r1, qf1, x[et], 0, 0, 0); }
    const float qd = exp2f(lg2 * (float)(c + 1));
    float ss = 0.f;
#pragma unroll
    for (int et = 0; et < 4; ++et) { o[et] += x[et] * qd; ss += (o[et][0] * o[et][0] + o[et][1] * o[et][1]) + (o[et][2] * o[et][2] + o[et][3] * o[et][3]); }
    ss += __shfl_xor(ss, 16); ss += __shfl_xor(ss, 32);
    const float ri = rsqrtf(ss * (1.f / 64.f) + EPS);
    const bool head_rows = (n == 0 && c < 8);
#pragma unroll
    for (int et = 0; et < 4; ++et) { const int e0 = 16 * et + 4 * fq;
        const u32x2 gw = *(const u32x2*)(RG + row * 256 + h * 64 + e0); const f32x4 gg = *(const f32x4*)(a.in[I_RETG] + l * 64 + e0);
        u32x2 ow; ow.x = cvt_pk_bf16(o[et][0] * ri * gg[0] * bflo(gw.x), o[et][1] * ri * gg[1] * bfhi(gw.x)); ow.y = cvt_pk_bf16(o[et][2] * ri * gg[2] * bflo(gw.y), o[et][3] * ri * gg[3] * bfhi(gw.y));
        if (!head_rows) *(u32x2*)(OC + row * 1024 + 512 + h * 64 + e0) = ow; }
    if (n == 0) {
        __syncthreads();
        float* pr = (float*)lds;
        { const float* hx = (const float*)(ws + WS_HX); const float* ssqv = (const float*)(ws + WS_SSQ);
#pragma unroll
          for (int i = 0; i < 4; ++i) { const int e = tid + i * 512, t = e >> 8, cc = e & 255;
              pr[e] = hx[(size_t)(b * 8 + t) * 1024 + (cc >> 6) * 256 + h * 64 + (cc & 63)] * row_scale(ssqv, b * SEQ + t); } }
        __syncthreads();
        { const int t = tid >> 6, i = tid & 31, isk = (tid >> 5) & 1; float* p = pr + t * 256 + isk * 64;
          const float* ctb = (const float*)(ws + WS_ROT); const float cs = ctb[t * 32 + i], sn = ctb[4096 * 32 + t * 32 + i];
          const float x1 = p[i], x2 = p[i + 32], sc = isk ? 0.125f : 1.f;
          p[i] = (x1 * cs - x2 * sn) * sc; p[i + 32] = (x2 * cs + x1 * sn) * sc; }
        __syncthreads();
        { const int t = tid >> 6, e = tid & 63; float o = 0.f;
          for (int j = 0; j <= t; ++j) { float d = 0.f;
              for (int dd = 0; dd < 64; ++dd) d += pr[t * 256 + dd] * pr[j * 256 + 64 + dd];
              o += d * exp2f(lg2 * (float)(t - j)) * pr[j * 256 + 128 + e]; }
          const float ss2 = wave_sum(o * o); const float ri2 = rsqrtf(ss2 * (1.f / 64.f) + EPS);
          const float gv = pr[t * 256 + 192 + e];
          const float val = o * ri2 * a.in[I_RETG][l * 64 + e] * gv * sigmoidf_(gv);
          OC[((size_t)b * SEQ + t) * 1024 + 512 + h * 64 + e] = (bf16_t)(cvt_pk_bf16(val, 0.f) & 0xffffu); }
    }
}
__device__ __forceinline__ void phase_B2(CArgs& a, int l, unsigned char* lds, const int tid, const int bx, const int G) {
    unsigned char* ws = a.ws; unsigned char* R = ws + WS_R;
    const int lane = tid & 63, wave = tid >> 6;
    const int gw = bx * NWAVES + wave, NGW = G * NWAVES;
    for (int up = bx; up < 1024; up += G) { const int u = (up & ~31) | ((up + 8 * (up >> 8)) & 31);
        retout_unit(a, l, lds, u, tid); }
    const float lam = ((const float*)(ws + WS_LAM))[l];
    const float post = 1.f - (0.8f - 0.6f * expf(-0.3f * (float)l));
    const bf16_t* OR = (const bf16_t*)(ws + WS_XB); bf16_t* OC = (bf16_t*)(R + R_OCAT);
    const bf16_t* SB = (const bf16_t*)(R + R_SCB); const bf16_t* SC = (const bf16_t*)(R + R_SCC); const bf16_t* SX = (const bf16_t*)(R + R_SCX);
#pragma unroll 4
    for (int row = gw; row < MT; row += NGW) {
        {
            const int h = lane >> 4, e0 = (lane & 15) * 8;
            const u32x4 w0 = *(const u32x4*)(OR + (size_t)row * 1024 + h * 256 + e0), w1 = *(const u32x4*)(OR + (size_t)row * 1024 + h * 256 + 128 + e0);
            float v[8] = {bflo(w0.x) - lam * bflo(w1.x), bfhi(w0.x) - lam * bfhi(w1.x), bflo(w0.y) - lam * bflo(w1.y), bfhi(w0.y) - lam * bfhi(w1.y),
                          bflo(w0.z) - lam * bflo(w1.z), bfhi(w0.z) - lam * bfhi(w1.z), bflo(w0.w) - lam * bflo(w1.w), bfhi(w0.w) - lam * bfhi(w1.w)};
            float s = 0.f;
#pragma unroll
            for (int i = 0; i < 8; ++i) s += v[i] * v[i];
            s += __shfl_xor(s, 1); s += __shfl_xor(s, 2); s += __shfl_xor(s, 4); s += __shfl_xor(s, 8);
            const float r = rsqrtf(s * (1.f / 128.f) + EPS) * post; const float* g = a.in[I_SUBLN] + l * 128 + e0;
            u32x4 o; o.x = cvt_pk_bf16(v[0] * r * g[0], v[1] * r * g[1]); o.y = cvt_pk_bf16(v[2] * r * g[2], v[3] * r * g[3]);
            o.z = cvt_pk_bf16(v[4] * r * g[4], v[5] * r * g[5]); o.w = cvt_pk_bf16(v[6] * r * g[6], v[7] * r * g[7]);
            *(u32x4*)(OC + (size_t)row * 1024 + h * 128 + e0) = o;
        }
        if (lane < 32) {
            const int ch = lane * 8, pos = row & (SEQ - 1);
            const float* cw = a.in[I_SCW] + l * 3 * 256 + ch; const float* cb = a.in[I_SCB] + l * 256 + ch;
            float y[8];
#pragma unroll
            for (int i = 0; i < 8; ++i) y[i] = cb[i];
#pragma unroll
            for (int k = 0; k < 3; ++k) { const int dt = 2 - k; if (pos >= dt) {
                const u32x4 cv = *(const u32x4*)(SC + (size_t)(row - dt) * 256 + ch), xv = *(const u32x4*)(SX + (size_t)(row - dt) * 256 + ch); const float* w = cw + k * 256;
                y[0] += w[0] * bflo(cv.x) * bflo(xv.x); y[1] += w[1] * bfhi(cv.x) * bfhi(xv.x); y[2] += w[2] * bflo(cv.y) * bflo(xv.y); y[3] += w[3] * bfhi(cv.y) * bfhi(xv.y);
                y[4] += w[4] * bflo(cv.z) * bflo(xv.z); y[5] += w[5] * bfhi(cv.z) * bfhi(xv.z); y[6] += w[6] * bflo(cv.w) * bflo(xv.w); y[7] += w[7] * bfhi(cv.w) * bfhi(xv.w); } }
            const u32x4 bv = *(const u32x4*)(SB + (size_t)row * 256 + ch);
            u32x4 o; o.x = cvt_pk_bf16(y[0] * bflo(bv.x), y[1] * bfhi(bv.x)); o.y = cvt_pk_bf16(y[2] * bflo(bv.y), y[3] * bfhi(bv.y));
            o.z = cvt_pk_bf16(y[4] * bflo(bv.z), y[5] * bfhi(bv.z)); o.w = cvt_pk_bf16(y[6] * bflo(bv.w), y[7] * bfhi(bv.w));
            *(u32x4*)(OC + (size_t)row * 1024 + 768 + ch) = o;
        }
    }
}

__device__ __forceinline__ void phase_F(CArgs& a, int l, const int tid, const int bx, const int G) {
    unsigned char* R = a.ws + WS_R;
    const bf16_t* Gb = (const bf16_t*)(R + R_G); bf16_t* U = (bf16_t*)(R + R_U);
    const int gt = bx * NTHR + tid, NGT = G * NTHR;
    constexpr int CPR = DFF / 8, SEGR = 32, NSEG = MT / SEGR;
    for (int it = gt; it < NSEG * CPR; it += NGT) {
        const int seg = it / CPR, ch = (it - seg * CPR) * 8, row0 = seg * SEGR;
        const float* cw = a.in[I_FCW] + (size_t)l * 3 * DFF + ch; const float* cbp = a.in[I_FCB] + (size_t)l * DFF + ch;
        const f32x4 w0a = *(const f32x4*)(cw), w0b = *(const f32x4*)(cw + 4), w1a = *(const f32x4*)(cw + DFF), w1b = *(const f32x4*)(cw + DFF + 4), w2a = *(const f32x4*)(cw + 2 * DFF), w2b = *(const f32x4*)(cw + 2 * DFF + 4);
        const f32x4 cba = *(const f32x4*)(cbp), cbb = *(const f32x4*)(cbp + 4);
        u32x4 gm2 = (u32x4){0u, 0u, 0u, 0u}, gm1 = (u32x4){0u, 0u, 0u, 0u};
        if ((row0 & (SEQ - 1)) != 0) { gm2 = *(const u32x4*)(Gb + (size_t)(row0 - 2) * DFF + ch); gm1 = *(const u32x4*)(Gb + (size_t)(row0 - 1) * DFF + ch); }
#pragma unroll 8
        for (int r = 0; r < SEGR; ++r) {
            const size_t off = (size_t)(row0 + r) * DFF + ch;
            const u32x4 g0 = *(const u32x4*)(Gb + off); const u32x4 uv = *(const u32x4*)(U + off);
            f32x4 ya = cba, yb = cbb;
            ya += w0a * (f32x4){bflo(gm2.x), bfhi(gm2.x), bflo(gm2.y), bfhi(gm2.y)}; yb += w0b * (f32x4){bflo(gm2.z), bfhi(gm2.z), bflo(gm2.w), bfhi(gm2.w)};
            ya += w1a * (f32x4){bflo(gm1.x), bfhi(gm1.x), bflo(gm1.y), bfhi(gm1.y)}; yb += w1b * (f32x4){bflo(gm1.z), bfhi(gm1.z), bflo(gm1.w), bfhi(gm1.w)};
            ya += w2a * (f32x4){bflo(g0.x), bfhi(g0.x), bflo(g0.y), bfhi(g0.y)};     yb += w2b * (f32x4){bflo(g0.z), bfhi(g0.z), bflo(g0.w), bfhi(g0.w)};
#pragma unroll
            for (int i = 0; i < 4; ++i) { ya[i] = ya[i] * sigmoidf_(ya[i]); yb[i] = yb[i] * sigmoidf_(yb[i]); }
            u32x4 o; o.x = cvt_pk_bf16(ya[0] * bflo(uv.x), ya[1] * bfhi(uv.x)); o.y = cvt_pk_bf16(ya[2] * bflo(uv.y), ya[3] * bfhi(uv.y));
            o.z = cvt_pk_bf16(yb[0] * bflo(uv.z), yb[1] * bfhi(uv.z)); o.w = cvt_pk_bf16(yb[2] * bflo(uv.w), yb[3] * bfhi(uv.w));
            *(u32x4*)(U + off) = o;
            gm2 = gm1; gm1 = g0;
        }
    }
}
constexpr int PH_PER_LAYER = 9, NPH = PH_PER_LAYER * DEPTH;
__global__ void __launch_bounds__(NTHR, 2) mk_fwd(Args a_by_value) {
    extern __shared__ __attribute__((aligned(16))) unsigned char lds[];
    LAS unsigned char* ldsl = (LAS unsigned char*)lds;
    const int ph_lo = a_by_value.ph_lo, ph_hi = a_by_value.ph_hi;
    const int wave_s = __builtin_amdgcn_readfirstlane((int)threadIdx.x >> 6);
#define PHASE_ENTER(k) int tid, wv_ = wave_s, bx = blockIdx.x, G = gridDim.x, l = lq; CArgs* ka = (CArgs*)__builtin_amdgcn_kernarg_segment_ptr(); \
        asm volatile("; phase " #k "\n\tv_mbcnt_lo_u32_b32 %0, -1, 0\n\tv_mbcnt_hi_u32_b32 %0, -1, %0\n\tv_lshl_or_b32 %0, %1, 6, %0" : "=&v"(tid), "+s"(wv_), "+s"(l), "+s"(bx), "+s"(G), "+s"(ka)); CArgs& a = *ka; unsigned char* ws = a.ws; unsigned char* R = ws + WS_R; (void)R; (void)G; (void)bx; (void)tid
    for (int ph = ph_lo; ph < ph_hi; ++ph) {
        int lq = ph / PH_PER_LAYER, p = ph - lq * PH_PER_LAYER;
        asm volatile("" : "+s"(lq), "+s"(p));
        if (p == 0) { PHASE_ENTER(0); phase_W(a, l, ldsl, tid, bx, G); }
        else if (p == 1) {
            PHASE_ENTER(1);
            reduce_hx(ws, tid, bx, G);
            pg8::Gemm g{(const bf16_t*)(ws + WS_XB), (const bf16_t*)(ws + WS_WIN), DM}; pg8::Order S; S.init(MT, INW, G, bx, 1, DM / 64);
            EpiSplit<0> E{R, (const float*)(ws + WS_SSQ), a.in[I_BGATE] + l * 3072, a.in[I_QG] + l * 64, a.in[I_KG] + l * 64, (const float*)(ws + WS_ROT)};
            pg8::gemm_phase(ldsl, g, S, E, tid);
        }
        else if (p == 2) { PHASE_ENTER(2); phase_B1(a, l, lds, tid, bx, G); }
        else if (p == 3) { PHASE_ENTER(3); phase_B2(a, l, lds, tid, bx, G); }
        else if (p == 4) {
            PHASE_ENTER(4);
            pg8::Gemm g{(const bf16_t*)(R + R_OCAT), (const bf16_t*)(ws + WS_WBR), DM}; pg8::Order S; S.init(MT, DM, G, bx, 1, DM / 64);
            EpiAcc E{(const bf16_t*)(R + R_GATES), (bf16_t*)(R + R_Y)};
            pg8::gemm_phase(ldsl, g, S, E, tid);
        }
        else if (p == 5) {
            PHASE_ENTER(5);
            pg8::Gemm g{(const bf16_t*)(R + R_Y), (const bf16_t*)(ws + WS_WOUT), DM}; pg8::Order S; S.init(MT, DM, G, bx, 1, DM / 64);
            EpiRes E{l == 0 ? a.in[I_X] : a.out, a.out, (bf16_t*)(ws + WS_XB), (float*)(ws + WS_SSQ)};
            pg8::gemm_phase(ldsl, g, S, E, tid);
        }
        else if (p == 6) {
            PHASE_ENTER(6);
            pg8::Gemm g{(const bf16_t*)(ws + WS_XB), (const bf16_t*)(ws + WS_WFFI), DM}; pg8::Order S; S.init(MT, 2 * DFF, G, bx, 1, DM / 64);
            EpiSplit<1> E{R, (const float*)(ws + WS_SSQ), nullptr, nullptr, nullptr, nullptr};
            pg8::gemm_phase(ldsl, g, S, E, tid);
        }
        else if (p == 7) { PHASE_ENTER(7); phase_F(a, l, tid, bx, G); }
        else {
            PHASE_ENTER(8);
            pg8::Gemm g{(const bf16_t*)(R + R_U), (const bf16_t*)(ws + WS_WFFO), DFF}; pg8::Order S; S.init(MT, DM, G, bx, 1, DFF / 64);
            EpiRes E{a.out, a.out, (bf16_t*)(ws + WS_XB), (float*)(ws + WS_SSQ)};
            pg8::gemm_phase(ldsl, g, S, E, tid);
        }
        if (ph + 1 < ph_hi) cg::this_grid().sync();
    }
}

extern "C" void kernel_launch(void* const* d_in, const int* in_sizes, int n_in, void* d_out, int out_size, void* d_ws, size_t ws_size, hipStream_t stream) {
    static int grid = 0;
    if (grid == 0) {
        if (n_in != 21 || out_size != MT * DM || ws_size < WS_END) { fprintf(stderr, "kernel_launch: unexpected problem (n_in %d out %d ws %zu)\n", n_in, out_size, ws_size); grid = -1; return; }
        int dev = 0, cus = 0;
        hipGetDevice(&dev); hipDeviceGetAttribute(&cus, hipDeviceAttributeMultiprocessorCount, dev);
        if (hipFuncSetAttribute((const void*)mk_fwd, hipFuncAttributeMaxDynamicSharedMemorySize, LDS_BYTES) != hipSuccess) { fprintf(stderr, "kernel_launch: hipFuncSetAttribute failed\n"); grid = -1; return; }
        int per_cu = 0;
        if (hipOccupancyMaxActiveBlocksPerMultiprocessor(&per_cu, (const void*)mk_fwd, NTHR, LDS_BYTES) != hipSuccess || per_cu < 1) fprintf(stderr, "kernel_launch: occupancy query says %d\n", per_cu);
        (void)hipGetLastError();
        grid = cus > 0 ? cus : 256;
    }
    if (grid < 0) return;
    Args a{};
    for (int i = 0; i < 21; ++i) a.in[i] = (const float*)d_in[i];
    a.out = (float*)d_out; a.ws = (unsigned char*)d_ws;
#if MK_ONE_LAUNCH
    a.ph_lo = 0; a.ph_hi = NPH;
    void* args[] = {&a};
    hipError_t e = hipLaunchCooperativeKernel((const void*)mk_fwd, dim3(grid), dim3(NTHR), args, LDS_BYTES, stream);
    if (e != hipSuccess) fprintf(stderr, "cooperative launch failed: %s (grid %d)\n", hipGetErrorString(e), grid);
#else
    for (int ph = 0; ph < NPH; ++ph) {
        a.ph_lo = ph; a.ph_hi = ph + 1;
        hipLaunchKernelGGL(mk_fwd, dim3(grid), dim3(NTHR), LDS_BYTES, stream, a);
    }
#endif
}
```
